# Optimizing an MI355X kernel written in HIP

```python
import math
import jax, jax.numpy as jnp
from jax import lax
import numpy as np

D_MODEL = 1024
BATCH = 8
SEQ = 4096
DEPTH = 2

N_MIXERS = 2
GRID_W = 64
NA_HEADS = 16
NA_HEAD_DIM = D_MODEL // NA_HEADS
NA_WIN_ROWS = 8
NA_WIN_COLS = 16
FN_GROUPS = 8
FN_GROUP_DIM = D_MODEL // FN_GROUPS
D_FF = ((8 * D_MODEL // 3 + 127) // 128) * 128
CONV_W = 3
LN_EPS = 1e-5
ALPHA = (2.0 * DEPTH) ** 0.25
BETA = (8.0 * DEPTH) ** -0.25
N_NA_LAYERS = (DEPTH + 1) // 2
N_FN_LAYERS = DEPTH // 2

kernel_name = "hybrid_natten_fnet_convffn_deepnorm_adaln"


def layer_norm(x, g, b):
    xf = x.astype(jnp.float32)
    mu = jnp.mean(xf, axis=-1, keepdims=True)
    var = jnp.mean(jnp.square(xf - mu), axis=-1, keepdims=True)
    y = (xf - mu) * lax.rsqrt(var + LN_EPS)
    return (y * g.astype(jnp.float32) + b.astype(jnp.float32)).astype(x.dtype)


def neighborhood_attention(u, w_qkv, rpb, w_o):
    B, S, D = u.shape
    rows = S // GRID_W
    kr = min(NA_WIN_ROWS, rows)
    qkv = jnp.einsum('bsd,de->bse', u, w_qkv)
    q, k, v = jnp.split(qkv, 3, axis=-1)
    grid = lambda t: t.reshape(B, rows, GRID_W, NA_HEADS, NA_HEAD_DIM)
    q = grid(q) * (NA_HEAD_DIM ** -0.5)
    k = grid(k)
    v = grid(v)
    qcol = np.arange(GRID_W)
    col_start = np.clip(qcol - NA_WIN_COLS // 2, 0, GRID_W - NA_WIN_COLS)
    kcol = np.arange(GRID_W)
    col_in = (kcol[None, :] >= col_start[:, None]) & (kcol[None, :] < col_start[:, None] + NA_WIN_COLS)
    dc_idx = np.clip(kcol[None, :] - qcol[:, None] + NA_WIN_COLS - 1, 0, 2 * NA_WIN_COLS - 2)
    row_start = np.clip(np.arange(rows) - kr // 2, 0, rows - kr)
    col_mask = jnp.asarray(col_in)[None, None, :, None, :]

    def one_row(args):
        r, rs = args
        q_r = lax.dynamic_index_in_dim(q, r, axis=1, keepdims=False)
        k_b = lax.dynamic_slice_in_dim(k, rs, kr, axis=1)
        v_b = lax.dynamic_slice_in_dim(v, rs, kr, axis=1)
        s = jnp.einsum('bqhd,bikhd->bhqik', q_r, k_b, preferred_element_type=jnp.float32)
        dr_idx = rs + jnp.arange(kr) - r + NA_WIN_ROWS - 1
        bias = rpb[:, dr_idx[None, :, None], dc_idx[:, None, :]]
        s = s + bias[None].astype(jnp.float32)
        s = jnp.where(col_mask, s, -jnp.inf)
        p = jax.nn.softmax(s.reshape(B, NA_HEADS, GRID_W, kr * GRID_W), axis=-1)
        p = p.reshape(B, NA_HEADS, GRID_W, kr, GRID_W).astype(v_b.dtype)
        return jnp.einsum('bhqik,bikhd->bqhd', p, v_b)

    out = lax.map(one_row, (jnp.arange(rows, dtype=jnp.int32), jnp.asarray(row_start, dtype=jnp.int32)))
    out = jnp.transpose(out, (1, 0, 2, 3, 4)).reshape(B, S, D)
    return jnp.einsum('bsd,de->bse', out, w_o)


def fourier_mix(u, w_o):
    B, S, D = u.shape
    ug = u.astype(jnp.float32).reshape(B, S, FN_GROUPS, FN_GROUP_DIM)
    y = jnp.fft.fftn(ug, axes=(1, 3), norm='ortho').real
    y = y.reshape(B, S, D).astype(u.dtype)
    return jnp.einsum('bsd,de->bse', y, w_o)


def conv_ffn(u, w_up, conv_w, conv_b, w_down):
    S = u.shape[1]
    a, g = jnp.split(jnp.einsum('bsd,df->bsf', u, w_up), 2, axis=-1)
    half = CONV_W // 2
    ap = jnp.pad(a, ((0, 0), (half, half), (0, 0)))
    a = conv_b + sum(ap[:, j:j + S] * conv_w[j] for j in range(CONV_W))
    h = jax.nn.gelu(a) * g
    return jnp.einsum('bsf,fd->bsd', h, w_down)


def setup_inputs(seed: int = 0) -> dict:
    key = jax.random.key(seed)
    ks = jax.random.split(key, 20)
    D, F = D_MODEL, D_FF
    nrm = lambda k, shape, s: jax.random.normal(k, shape, jnp.float32) * s
    x = nrm(ks[0], (BATCH, SEQ, D), 1.0)
    c = nrm(ks[1], (BATCH, D), 1.0)
    ada_w = nrm(ks[2], (DEPTH, D, 6 * D), 0.1 * D ** -0.5)
    ada_b = nrm(ks[3], (DEPTH, 6 * D), 0.01)
    w_qk = nrm(ks[4], (N_NA_LAYERS, D, 2 * D), D ** -0.5)
    w_v = nrm(ks[5], (N_NA_LAYERS, D, D), BETA * D ** -0.5)
    na_w_qkv = jnp.concatenate([w_qk, w_v], axis=-1)
    na_rpb = nrm(ks[6], (N_NA_LAYERS, NA_HEADS, 2 * NA_WIN_ROWS - 1, 2 * NA_WIN_COLS - 1), 0.02)
    na_w_o = nrm(ks[7], (N_NA_LAYERS, D, D), BETA * D ** -0.5)
    fn_w_o = nrm(ks[8], (N_FN_LAYERS, D, D), BETA * D ** -0.5)
    ln1_g = 1.0 + nrm(ks[9], (DEPTH, D), 0.01)
    ln1_b = nrm(ks[10], (DEPTH, D), 0.01)
    ffn_w_up = nrm(ks[11], (DEPTH, D, 2 * F), BETA * D ** -0.5)
    ffn_conv_w = nrm(ks[12], (DEPTH, CONV_W, F), CONV_W ** -0.5)
    ffn_conv_b = nrm(ks[13], (DEPTH, F), 0.01)
    ffn_w_down = nrm(ks[14], (DEPTH, F, D), BETA * F ** -0.5)
    ln2_g = 1.0 + nrm(ks[15], (DEPTH, D), 0.01)
    ln2_b = nrm(ks[16], (DEPTH, D), 0.01)
    return {"x": x, "c": c, "ada_w": ada_w, "ada_b": ada_b,
            "na_w_qkv": na_w_qkv, "na_rpb": na_rpb, "na_w_o": na_w_o, "fn_w_o": fn_w_o,
            "ln1_g": ln1_g, "ln1_b": ln1_b,
            "ffn_w_up": ffn_w_up, "ffn_conv_w": ffn_conv_w, "ffn_conv_b": ffn_conv_b, "ffn_w_down": ffn_w_down,
            "ln2_g": ln2_g, "ln2_b": ln2_b}


def reference(x, c, ada_w, ada_b, na_w_qkv, na_rpb, na_w_o, fn_w_o, ln1_g, ln1_b,
              ffn_w_up, ffn_conv_w, ffn_conv_b, ffn_w_down, ln2_g, ln2_b):
    cs = jax.nn.silu(c)
    for i in range(DEPTH):
        mod = jnp.einsum('bd,de->be', cs, ada_w[i]) + ada_b[i]
        sh1, sc1, g1, sh2, sc2, g2 = jnp.split(mod[:, None, :], 6, axis=-1)
        u = x * (1.0 + sc1) + sh1
        j = i // N_MIXERS
        if i % N_MIXERS == 0:
            y = neighborhood_attention(u, na_w_qkv[j], na_rpb[j], na_w_o[j])
        else:
            y = fourier_mix(u, fn_w_o[j])
        x = layer_norm(ALPHA * x + (1.0 + g1) * y, ln1_g[i], ln1_b[i])
        u = x * (1.0 + sc2) + sh2
        y = conv_ffn(u, ffn_w_up[i], ffn_conv_w[i], ffn_conv_b[i], ffn_w_down[i])
        x = layer_norm(ALPHA * x + (1.0 + g2) * y, ln2_g[i], ln2_b[i])
    return x
```

```cpp
#include <hip/hip_runtime.h>
#include <hip/hip_cooperative_groups.h>
#include <cstdio>
#include <cstdint>
namespace cg = cooperative_groups;

#ifndef MK_ONE_LAUNCH
#define MK_ONE_LAUNCH 1
#endif

namespace pg8 {
#define PG8_LAS __attribute__((address_space(3)))
typedef _Float16 h16;
typedef _Float16 h16x8 __attribute__((ext_vector_type(8)));
typedef _Float16 h16x2 __attribute__((ext_vector_type(2)));
typedef float f32x4 __attribute__((ext_vector_type(4)));
typedef float f32x2 __attribute__((ext_vector_type(2)));
typedef unsigned u32x4 __attribute__((ext_vector_type(4)));
typedef unsigned u32x2 __attribute__((ext_vector_type(2)));
constexpr int BM = 256, BK = 64, HALF = 128, HTB = HALF * BK * 2  , STAGE_BYTES = 8 * HTB, NXCD = 8, WGM = 8;

__host__ __device__ __forceinline__ int lds_byte(int r, int c) { const int st = (r >> 4) * 2 + (c >> 5), rr = r & 15, cc = c & 31, ob = rr * 64 + cc * 2; return st * 1024 + (ob ^ (((ob >> 9) & 1) << 5)); }
__host__ __device__ __forceinline__ void stage_rc(int b, int& R, int& C) { const int st = b / 1024, sb = b % 1024, swz = sb ^ (((sb >> 9) & 1) << 5); R = (st >> 1) * 16 + swz / 64; C = (st & 1) * 32 + (swz % 64) / 2; }
__host__ __device__ __forceinline__ int perm32(int rho) { const int n = rho >> 4, i = rho & 15; return 8 * (i >> 2) + 4 * n + (i & 3); }

struct Unit { int pm, pn; };
struct Gemm { const h16* A; const h16* Bt; int lda, ldb, K; size_t a_tile, b_tile, b_pm_koff; };

struct StaticOrder {
    int nM, nN, nwg, G, c;
    __host__ __device__ void init(int M, int N, int G_, int c_) { nM = M / BM; nN = N / BM; nwg = nM * nN; G = G_; c = c_; }
    __host__ __device__ bool next(int i, Unit& u) const {
        const long L = (long)i * G + c; if (L >= nwg) return false;
        int wgid = (int)L; { const int q = nwg / NXCD, r = nwg % NXCD, xcd = wgid % NXCD, off = wgid / NXCD; wgid = (xcd < r ? xcd * (q + 1) : r * (q + 1) + (xcd - r) * q) + off; }
        const int nig = WGM * nN, gid = wgid / nig, fm = gid * WGM, gsz = (nM - fm) < WGM ? (nM - fm) : WGM;
        u.pm = fm + ((wgid % nig) % gsz); u.pn = (wgid % nig) / gsz; return true;
    }
    __device__ __forceinline__ void a_ready(const Unit&) const {}
    __device__ __forceinline__ void done(const Unit&) const {}
};

__device__ __forceinline__ unsigned pk_h2(float lo, float hi) { h16x2 v; v.x = (h16)lo; v.y = (h16)hi; return __builtin_bit_cast(unsigned, v); }


struct EpiH16 {
    static constexpr bool PERM = true, AFTER_DRAIN = false;
    h16* O; int ldc; int split_cols; size_t split_stride; int scale_cols; float scale;
    __device__ __forceinline__ void operator()(const f32x4 (&acc)[2][2][4][2], const Unit& u, int wr, int wc, int fr, int fq) const {
        const int row0 = u.pm * BM + wr * 64 + fr; int colt = u.pn * BM; h16* base = O;
        const float sc = (colt < scale_cols) ? scale : 1.f;
        if (split_cols) { const int t = colt / split_cols; base += (size_t)t * split_stride; colt -= t * split_cols; }
        const int col0 = colt + wc * 32 + 8 * fq;
#pragma unroll
        for (int ai = 0; ai < 2; ++ai)
#pragma unroll
            for (int m = 0; m < 4; ++m) { h16* rowp = base + (size_t)(row0 + ai * HALF + m * 16) * ldc + col0;
#pragma unroll
                for (int bj = 0; bj < 2; ++bj) { const f32x4 v0 = acc[ai][bj][m][0] * sc, v1 = acc[ai][bj][m][1] * sc;
                    u32x4 w; w.x = pk_h2(v0[0], v0[1]); w.y = pk_h2(v0[2], v0[3]); w.z = pk_h2(v1[0], v1[1]); w.w = pk_h2(v1[2], v1[3]);
                    *(u32x4*)(rowp + bj * HALF) = w; } }
    }
};

struct EpiF1 {
    static constexpr bool PERM = true, AFTER_DRAIN = false;
    h16* PQT;
    __device__ __forceinline__ void operator()(const f32x4 (&acc)[2][2][4][2], const Unit& u, int wr, int wc, int fr, int fq) const {
        const int b = u.pn >> 4, s0 = (u.pn & 15) * 256 + wc * 32 + 8 * fq;
#pragma unroll
        for (int ai = 0; ai < 2; ++ai)
#pragma unroll
            for (int m = 0; m < 4; ++m) { h16* rowp = PQT + (size_t)(b * 1024 + u.pm * 128 + wr * 64 + m * 16 + fr) * 8192 + ai * 4096 + s0;
#pragma unroll
                for (int bj = 0; bj < 2; ++bj) { const f32x4 v0 = acc[ai][bj][m][0], v1 = acc[ai][bj][m][1];
                    u32x4 w; w.x = pk_h2(v0[0], v0[1]); w.y = pk_h2(v0[2], v0[3]); w.z = pk_h2(v1[0], v1[1]); w.w = pk_h2(v1[2], v1[3]);
                    *(u32x4*)(rowp + bj * HALF) = w; } }
    }
};

struct EpiRes {
    static constexpr bool PERM = false, AFTER_DRAIN = false;
    const float* res; const float* stats; const float* gam; const float* bet; const float* gate; float* out;
    __device__ __forceinline__ void operator()(const f32x4 (&acc)[2][2][4][2], const Unit& u, int wr, int wc, int fr, int fq) const {
        const int b = u.pm >> 4; const float ALPHA = 1.41421356237f;
#pragma unroll
        for (int bj = 0; bj < 2; ++bj)
#pragma unroll
            for (int n = 0; n < 2; ++n) {
                const int col = u.pn * BM + bj * HALF + wc * 32 + n * 16 + 4 * fq;
                const f32x4 gt = *(const f32x4*)(gate + b * 6144 + col) + 1.0f;
                f32x4 gm = (f32x4){1.f, 1.f, 1.f, 1.f}, bt = (f32x4){0.f, 0.f, 0.f, 0.f};
                if (stats) { gm = *(const f32x4*)(gam + col); bt = *(const f32x4*)(bet + col); }
#pragma unroll
                for (int ai = 0; ai < 2; ++ai)
#pragma unroll
                    for (int m = 0; m < 4; ++m) {
                        const int row = u.pm * BM + ai * HALF + wr * 64 + m * 16 + fr;
                        f32x4 r = *(const f32x4*)(res + (size_t)row * 1024 + col);
                        if (stats) { const f32x2 st = *(const f32x2*)(stats + 2 * row); r = (r - st.x) * st.y * gm + bt; }
                        const f32x4 o = r * ALPHA + gt * acc[ai][bj][m][n];
                        *(f32x4*)(out + (size_t)row * 1024 + col) = o;
                    }
            }
    }
};

__device__ __forceinline__ float dpp_prev(float old, float src) {
    return __builtin_bit_cast(float, __builtin_amdgcn_update_dpp(__builtin_bit_cast(int, old), __builtin_bit_cast(int, src), 0x111, 0xf, 0xf, false)); }
__device__ __forceinline__ float dpp_next(float old, float src) {
    return __builtin_bit_cast(float, __builtin_amdgcn_update_dpp(__builtin_bit_cast(int, old), __builtin_bit_cast(int, src), 0x101, 0xf, 0xf, false)); }
__device__ __forceinline__ float dpp_ror1(float src) {
    return __builtin_bit_cast(float, __builtin_amdgcn_update_dpp(0, __builtin_bit_cast(int, src), 0x121, 0xf, 0xf, false)); }
__device__ __forceinline__ float dpp_ror15(float src) {
    return __builtin_bit_cast(float, __builtin_amdgcn_update_dpp(0, __builtin_bit_cast(int, src), 0x12f, 0xf, 0xf, false)); }
__device__ __forceinline__ float gelu_tanh(float v) {
    const float y = v + 0.044715f * v * v * v;
    const float e = __builtin_amdgcn_exp2f(-2.302208198f * y);
    return v * __builtin_amdgcn_rcpf(1.0f + e);
}

struct EpiUp {
    static constexpr bool PERM = true, AFTER_DRAIN = false;
    const float* cw; const float* cb; h16* H; float* edge;
    __device__ __forceinline__ void operator()(const f32x4 (&acc)[2][2][4][2], const Unit& u, int wr, int wc, int fr, int fq) const {
        const int f0 = u.pn * 128 + wc * 32 + 8 * fq;
        f32x4 w0[2], w1[2], w2[2], bb[2];
#pragma unroll
        for (int n = 0; n < 2; ++n) { w0[n] = *(const f32x4*)(cw + f0 + 4 * n); w1[n] = *(const f32x4*)(cw + 2816 + f0 + 4 * n); w2[n] = *(const f32x4*)(cw + 2 * 2816 + f0 + 4 * n); bb[n] = *(const f32x4*)(cb + f0 + 4 * n); }
#pragma unroll
        for (int ai = 0; ai < 2; ++ai) {
            const int blk = u.pm * 4 + ai * 2 + wr;
            float* eb = edge + (size_t)blk * 6 * 2816 + f0;
#pragma unroll
            for (int m = 0; m < 4; ++m) {
                unsigned pk[4];
#pragma unroll
                for (int n = 0; n < 2; ++n) {
                    const f32x4 a = acc[ai][0][m][n], g = acc[ai][1][m][n];
                    f32x4 hv;
#pragma unroll
                    for (int j = 0; j < 4; ++j) {
                        const float po = (m > 0) ? dpp_ror1(acc[ai][0][m > 0 ? m - 1 : 0][n][j]) : 0.f;
                        const float no = (m < 3) ? dpp_ror15(acc[ai][0][m < 3 ? m + 1 : 3][n][j]) : 0.f;
                        const float p = dpp_prev(po, a[j]), q = dpp_next(no, a[j]);
                        const float v = bb[n][j] + w0[n][j] * p + w1[n][j] * a[j] + w2[n][j] * q;
                        hv[j] = gelu_tanh(v) * g[j];
                    }
                    pk[2 * n] = pk_h2(hv[0], hv[1]); pk[2 * n + 1] = pk_h2(hv[2], hv[3]);
                    if (m == 0) { if (fr == 0) { *(f32x4*)(eb + 0 * 2816 + 4 * n) = a; *(f32x4*)(eb + 4 * 2816 + 4 * n) = g; } if (fr == 1) *(f32x4*)(eb + 1 * 2816 + 4 * n) = a; }
                    if (m == 3) { if (fr == 14) *(f32x4*)(eb + 2 * 2816 + 4 * n) = a; if (fr == 15) { *(f32x4*)(eb + 3 * 2816 + 4 * n) = a; *(f32x4*)(eb + 5 * 2816 + 4 * n) = g; } }
                }
                const int row = u.pm * BM + ai * HALF + wr * 64 + m * 16 + fr;
                u32x4 w; w.x = pk[0]; w.y = pk[1]; w.z = pk[2]; w.w = pk[3];
                *(u32x4*)(H + (size_t)row * 2816 + f0) = w;
            }
        }
    }
};

template <class Epi, class Sched, bool ALIGN_EPI = false, bool SP2 = false>
__device__ __forceinline__ void gemm_phase(PG8_LAS unsigned char* lds, const Gemm g, const Sched& S, const Epi& E) {
    int tid_ = threadIdx.x; asm volatile("" : "+v"(tid_));
    const int tid = tid_, wid = __builtin_amdgcn_readfirstlane(tid >> 6), lane = tid & 63, wr = wid >> 2, wc = wid & 3, fr = lane & 15, fq = lane >> 4;
    const int K = g.K, nt = K / BK;
    unsigned voffA[2], voffB[2];
#pragma unroll
    for (int i = 0; i < 2; ++i) { int R, C; stage_rc(tid * 16 + i * 8192, R, C); const int Rb = Epi::PERM ? ((R & ~31) + perm32(R & 31)) : R;
        voffA[i] = (unsigned)(R * g.lda + C) * 2u; voffB[i] = (unsigned)(Rb * g.ldb + C) * 2u; }
    const size_t kstep = (size_t)(BK * 2);
    const size_t hstepA = (size_t)HALF * g.lda * 2, hstepB = (size_t)HALF * g.ldb * 2;
    const unsigned ldsw = (unsigned)wid * 1024u;
    const int aoff = lds_byte(wr * 64 + fr, fq * 8), boff = lds_byte(wc * 32 + fr, fq * 8);
#define PG8_SA(b, h) (((b) * 2 + (h)) * HTB)
#define PG8_SB(b, h) ((4 + (b) * 2 + (h)) * HTB)
#define PG8_STAGE(bufoff, gbase, voff) do { _Pragma("unroll") for (int _i = 0; _i < 2; ++_i) \
        __builtin_amdgcn_global_load_lds((const unsigned*)((const char*)(gbase) + (voff)[_i]), (PG8_LAS unsigned*)(lds + (bufoff) + ldsw + _i * 8192), 16, 0, 0); } while (0)
#define PG8_LDA(dst, b, h) do { _Pragma("unroll") for (int m = 0; m < 4; ++m) _Pragma("unroll") for (int k = 0; k < 2; ++k) dst[m][k] = *(const PG8_LAS h16x8*)(lds + PG8_SA(b, h) + aoff + m * 2048 + k * 1024); } while (0)
#define PG8_LDB(dst, b, h) do { _Pragma("unroll") for (int n = 0; n < 2; ++n) _Pragma("unroll") for (int k = 0; k < 2; ++k) dst[n][k] = *(const PG8_LAS h16x8*)(lds + PG8_SB(b, h) + boff + n * 2048 + k * 1024); } while (0)
#define PG8_MMA(ai, bj, At, Bt) do { __builtin_amdgcn_s_setprio(1); _Pragma("unroll") for (int m = 0; m < 4; ++m) _Pragma("unroll") for (int n = 0; n < 2; ++n) _Pragma("unroll") for (int k = 0; k < 2; ++k) \
        acc[ai][bj][m][n] = __builtin_amdgcn_mfma_f32_16x16x32_f16(Bt[n][k], At[m][k], acc[ai][bj][m][n], 0, 0, 0); __builtin_amdgcn_s_setprio(0); } while (0)
#define PG8_WAIT_V(n) asm volatile("s_waitcnt vmcnt(" #n ")" ::: "memory")
#define PG8_WAIT_L(n) asm volatile("s_waitcnt lgkmcnt(" #n ")" ::: "memory")
#define PG8_BAR __builtin_amdgcn_s_barrier()
#define PG8_SCHED __builtin_amdgcn_sched_barrier(0)
    Unit cur, nxt; int ui = 0;
    if (!S.next(0, cur)) return;
    f32x4 acc[2][2][4][2];
#pragma unroll
    for (int a = 0; a < 2; ++a)
#pragma unroll
        for (int b = 0; b < 2; ++b)
#pragma unroll
            for (int m = 0; m < 4; ++m)
#pragma unroll
                for (int n = 0; n < 2; ++n) acc[a][b][m][n] = (f32x4){0.f, 0.f, 0.f, 0.f};
    h16x8 At[4][2], B0[2][2], B1[2][2];
    const char* cA = (const char*)g.A + (size_t)cur.pm * g.a_tile; const char* cB = (const char*)g.Bt + (size_t)cur.pn * g.b_tile + (size_t)cur.pm * g.b_pm_koff;
    S.a_ready(cur);
    if constexpr (SP2) {
        PG8_STAGE(PG8_SB(0, 0), cB, voffB); PG8_STAGE(PG8_SB(0, 1), cB + hstepB, voffB); PG8_STAGE(PG8_SA(0, 0), cA, voffA); PG8_STAGE(PG8_SA(0, 1), cA + hstepA, voffA);
        if (wr == 1) PG8_BAR;
        PG8_WAIT_V(2); PG8_BAR;
        PG8_STAGE(PG8_SB(1, 0), cB + kstep, voffB); PG8_STAGE(PG8_SA(1, 0), cA + kstep, voffA); PG8_STAGE(PG8_SB(1, 1), cB + hstepB + kstep, voffB);
        PG8_WAIT_V(6); PG8_BAR;
    } else {
        PG8_STAGE(PG8_SB(0, 0), cB, voffB); PG8_STAGE(PG8_SA(0, 0), cA, voffA); PG8_STAGE(PG8_SB(0, 1), cB + hstepB, voffB); PG8_STAGE(PG8_SA(0, 1), cA + hstepA, voffA);
        if (wr == 1) PG8_BAR;
        PG8_WAIT_V(4); PG8_BAR;
        PG8_STAGE(PG8_SB(1, 0), cB + kstep, voffB); PG8_STAGE(PG8_SA(1, 0), cA + kstep, voffA); PG8_STAGE(PG8_SB(1, 1), cB + hstepB + kstep, voffB);
        PG8_WAIT_V(6); PG8_BAR;
    }
    for (;;) {
        const bool has_next = S.next(ui + 1, nxt);
        const char* nA = has_next ? (const char*)g.A + (size_t)nxt.pm * g.a_tile : cA; const char* nB = has_next ? (const char*)g.Bt + (size_t)nxt.pn * g.b_tile + (size_t)nxt.pm * g.b_pm_koff : cB;
        for (int t = 0; t < nt; t += 2) {
            const bool last = (t == nt - 2);
            const char* a1 = cA + (size_t)(t + 1) * kstep;
            const char* a2 = last ? nA : cA + (size_t)(t + 2) * kstep; const char* b2 = last ? nB : cB + (size_t)(t + 2) * kstep;
            const char* a3 = a2 + kstep; const char* b3 = b2 + kstep;
            if (last && has_next) S.a_ready(nxt);
            if constexpr (SP2) {
            PG8_LDB(B0, 0, 0); PG8_LDB(B1, 0, 1); PG8_SCHED; PG8_LDA(At, 0, 0); PG8_STAGE(PG8_SA(1, 1), a1 + hstepA, voffA);
            PG8_WAIT_V(8); PG8_WAIT_L(0); PG8_BAR; PG8_MMA(0, 0, At, B0); PG8_MMA(0, 1, At, B1); PG8_BAR; PG8_SCHED;
            PG8_LDA(At, 0, 1); PG8_STAGE(PG8_SB(0, 0), b2, voffB); PG8_STAGE(PG8_SB(0, 1), b2 + hstepB, voffB); PG8_STAGE(PG8_SA(0, 0), a2, voffA);
            PG8_WAIT_V(8); PG8_WAIT_L(0); PG8_BAR; PG8_MMA(1, 0, At, B0); PG8_MMA(1, 1, At, B1); PG8_BAR; PG8_SCHED;
            PG8_LDB(B0, 1, 0); PG8_LDB(B1, 1, 1); PG8_SCHED; PG8_LDA(At, 1, 0); PG8_STAGE(PG8_SA(0, 1), a2 + hstepA, voffA);
            PG8_WAIT_V(8); PG8_WAIT_L(0); PG8_BAR; PG8_MMA(0, 0, At, B0); PG8_MMA(0, 1, At, B1); PG8_BAR; PG8_SCHED;
            PG8_LDA(At, 1, 1); PG8_STAGE(PG8_SB(1, 0), b3, voffB); PG8_STAGE(PG8_SB(1, 1), b3 + hstepB, voffB); PG8_STAGE(PG8_SA(1, 0), a3, voffA);
            PG8_WAIT_V(8); PG8_WAIT_L(0); PG8_BAR; PG8_MMA(1, 0, At, B0); PG8_MMA(1, 1, At, B1); PG8_BAR; PG8_SCHED;
            } else {
            PG8_LDB(B0, 0, 0); PG8_SCHED; PG8_LDA(At, 0, 0); PG8_STAGE(PG8_SA(1, 1), a1 + hstepA, voffA);
            PG8_WAIT_L(8); PG8_BAR; PG8_WAIT_L(0); PG8_MMA(0, 0, At, B0); PG8_BAR; PG8_SCHED;
            PG8_LDB(B1, 0, 1); PG8_STAGE(PG8_SB(0, 0), b2, voffB);
            PG8_BAR; PG8_WAIT_L(0); PG8_MMA(0, 1, At, B1); PG8_BAR;
            PG8_LDA(At, 0, 1); PG8_STAGE(PG8_SA(0, 0), a2, voffA);
            PG8_BAR; PG8_WAIT_L(0); PG8_MMA(1, 0, At, B0); PG8_BAR; PG8_SCHED;
            PG8_STAGE(PG8_SB(0, 1), b2 + hstepB, voffB);
            PG8_WAIT_V(6); PG8_BAR; PG8_MMA(1, 1, At, B1); PG8_BAR;
            PG8_LDB(B0, 1, 0); PG8_SCHED; PG8_LDA(At, 1, 0); PG8_STAGE(PG8_SA(0, 1), a2 + hstepA, voffA);
            PG8_WAIT_L(8); PG8_BAR; PG8_WAIT_L(0); PG8_MMA(0, 0, At, B0); PG8_BAR; PG8_SCHED;
            PG8_LDB(B1, 1, 1); PG8_STAGE(PG8_SB(1, 0), b3, voffB);
            PG8_BAR; PG8_WAIT_L(0); PG8_MMA(0, 1, At, B1); PG8_BAR;
            PG8_LDA(At, 1, 1); PG8_STAGE(PG8_SA(1, 0), a3, voffA);
            PG8_BAR; PG8_WAIT_L(0); PG8_MMA(1, 0, At, B0); PG8_BAR; PG8_SCHED;
            PG8_STAGE(PG8_SB(1, 1), b3 + hstepB, voffB);
            PG8_WAIT_V(6); PG8_BAR; PG8_MMA(1, 1, At, B1); PG8_BAR;
            }
        }
        if constexpr (ALIGN_EPI) { if (wr == 0) PG8_BAR; }
        if constexpr (!Epi::AFTER_DRAIN) { E(acc, cur, wr, wc, fr, fq); S.done(cur); }
        if (!has_next) break;
#pragma unroll
        for (int a = 0; a < 2; ++a)
#pragma unroll
            for (int b = 0; b < 2; ++b)
#pragma unroll
                for (int m = 0; m < 4; ++m)
#pragma unroll
                    for (int n = 0; n < 2; ++n) acc[a][b][m][n] = (f32x4){0.f, 0.f, 0.f, 0.f};
        cur = nxt; cA = nA; cB = nB; ++ui;
        if constexpr (ALIGN_EPI) { if (wr == 1) PG8_BAR; }
    }
    PG8_WAIT_V(0);
    if constexpr (!ALIGN_EPI) { if (wr == 0) PG8_BAR; }
    PG8_BAR;
    if constexpr (Epi::AFTER_DRAIN) { E.fused(acc, cur, wr, wc, fr, fq, lds, wid, lane); S.done(cur); }
#undef PG8_SA
#undef PG8_SB
#undef PG8_STAGE
#undef PG8_LDA
#undef PG8_LDB
#undef PG8_MMA
#undef PG8_WAIT_V
#undef PG8_WAIT_L
#undef PG8_BAR
#undef PG8_SCHED
}
}

using pg8::h16; using pg8::h16x8; using pg8::f32x4; using pg8::f32x2; using pg8::u32x4; using pg8::u32x2; using pg8::pk_h2;
#define LAS __attribute__((address_space(3)))
constexpr int NWAVES = 8;
constexpr int D = 1024, BATCH = 8, SEQ = 4096, M = BATCH * SEQ, FF = 2816, NH = 16, HD = 64;
constexpr float LN_EPS = 1e-5f;
constexpr size_t MiB = 1u << 20;
constexpr size_t WS_MOD = 0;
constexpr size_t WS_STATS = 1 * MiB;
constexpr size_t WS_DFT128 = 1 * MiB + 512 * 1024;
constexpr size_t WS_WQK = 2 * MiB, WS_WV = 6 * MiB, WS_WO = 8 * MiB, WS_FWO = 10 * MiB, WS_WUP0 = 12 * MiB, WS_WUP1 = 23 * MiB, WS_WDN0 = 34 * MiB, WS_WDN1 = 34 * MiB + 5632 * 1024, WS_EDGE = 46 * MiB;
constexpr size_t WS_U = 80 * MiB, WS_ZA = 144 * MiB, WS_BIG = 272 * MiB, WS_END = 464 * MiB;
constexpr size_t WS_QK = WS_BIG, WS_VT = WS_BIG + 128 * MiB, WS_H = WS_BIG, WS_PQT = WS_BIG, WS_F = WS_BIG + 128 * MiB;
static_assert(WS_WDN1 + 5632 * 1024 <= WS_EDGE && WS_EDGE + (size_t)512 * 6 * 2816 * 4 <= WS_U, "ws map");
constexpr int LDS_BYTES = 152 * 1024;
constexpr int ATT_K_OFF = 0, ATT_V_OFF = 73728, ATT_VSTRIDE = 1160, ATT_B_OFF = ATT_V_OFF + 64 * ATT_VSTRIDE;
static_assert(ATT_B_OFF + 2048 <= LDS_BYTES, "lds map");
constexpr int N_PHASES = 18;

struct Args { const float* in[16]; float* out; unsigned char* ws; int ph_lo, ph_hi, coop, pad; };

__device__ __forceinline__ float wave_sum(float v) {
#pragma unroll
    for (int o = 1; o < 64; o <<= 1) v += __shfl_xor(v, o);
    return v;
}
__device__ __forceinline__ int clipi(int v, int lo, int hi) { return v < lo ? lo : (v > hi ? hi : v); }

template <int KIND>
__device__ __forceinline__ void p0_transpose_item(const float* W, int ldw, int col0, int K, int ncols, h16* WT, LAS float* scr, int item, int lane) {
    const int nblk = ncols / 32, kb = item / nblk, nb = item % nblk, k0 = 64 * kb, n0 = 32 * nb;
#pragma unroll 8
    for (int i = 0; i < 32; ++i) { const int kk = 2 * i + (lane >> 5); scr[kk * 33 + (lane & 31)] = W[(size_t)(k0 + kk) * ldw + col0 + n0 + (lane & 31)]; }
    asm volatile("s_waitcnt lgkmcnt(0)" ::: "memory");
    const int c = lane & 7;
#pragma unroll
    for (int j = 0; j < 4; ++j) { const int n = (lane >> 3) + 8 * j; const LAS float* s = scr + (8 * c) * 33 + n;
        u32x4 o; o.x = pk_h2(s[0 * 33], s[1 * 33]); o.y = pk_h2(s[2 * 33], s[3 * 33]); o.z = pk_h2(s[4 * 33], s[5 * 33]); o.w = pk_h2(s[6 * 33], s[7 * 33]);
        int dr = n0 + n;
        if (KIND == 1) { const int f = dr % FF, isg = dr / FF; dr = (f >> 7) * 256 + isg * 128 + (f & 127); }
        *(u32x4*)(WT + (size_t)dr * K + k0 + 8 * c) = o; }
    asm volatile("s_waitcnt lgkmcnt(0)" ::: "memory");
}

template <int MODE>
__device__ __forceinline__ void ln_rows(const float* src, const float* gam, const float* bet, const float* modsh, const float* modsc, h16* U, float* stats, float* outf, int G, int wid, int lane) {
    const int gw = blockIdx.x * NWAVES + wid, NGW = G * NWAVES;
    f32x4 gm[4], bt[4];
    if (MODE != 0) {
#pragma unroll
        for (int j = 0; j < 4; ++j) { gm[j] = *((const f32x4*)gam + lane + 64 * j); bt[j] = *((const f32x4*)bet + lane + 64 * j); }
    }
    for (int row = gw; row < M; row += NGW) {
        const int b = row >> 12;
        const f32x4* xr = (const f32x4*)(src + (size_t)row * D) + lane;
        f32x4 v[4];
#pragma unroll
        for (int j = 0; j < 4; ++j) v[j] = xr[64 * j];
        if (MODE != 0) {
            float s = 0.f;
#pragma unroll
            for (int j = 0; j < 4; ++j) s += (v[j].x + v[j].y) + (v[j].z + v[j].w);
            const float mean = wave_sum(s) * (1.f / D); float s2 = 0.f;
#pragma unroll
            for (int j = 0; j < 4; ++j) { v[j] = v[j] - mean; s2 += (v[j].x * v[j].x + v[j].y * v[j].y) + (v[j].z * v[j].z + v[j].w * v[j].w); }
            const float rstd = 1.f / sqrtf(wave_sum(s2) * (1.f / D) + LN_EPS);
            if (MODE == 1 && lane == 0) *(f32x2*)(stats + 2 * row) = (f32x2){mean, rstd};
#pragma unroll
            for (int j = 0; j < 4; ++j) v[j] = v[j] * rstd * gm[j] + bt[j];
        }
        if (MODE == 2) {
            f32x4* o = (f32x4*)(outf + (size_t)row * D) + lane;
#pragma unroll
            for (int j = 0; j < 4; ++j) o[64 * j] = v[j];
        } else {
            const f32x4* sh = (const f32x4*)(modsh + b * 6144) + lane; const f32x4* sc = (const f32x4*)(modsc + b * 6144) + lane;
            u32x2* o8 = (u32x2*)(U + (size_t)row * D) + lane;
#pragma unroll
            for (int j = 0; j < 4; ++j) { const f32x4 t = v[j] * (sc[64 * j] + 1.0f) + sh[64 * j]; u32x2 w; w.x = pk_h2(t.x, t.y); w.y = pk_h2(t.z, t.w); o8[64 * j] = w; }
        }
    }
}

__device__ __forceinline__ void ffn_fixup(const float* edge, const float* cw, const float* cb, h16* H, int G) {
    const int total = 512 * 2 * (FF / 4);
    for (int it = blockIdx.x * 512 + threadIdx.x; it < total; it += G * 512) {
        const int f4 = it % (FF / 4), rest = it / (FF / 4), which = rest & 1, blk = rest >> 1, f = 4 * f4;
        const float* eb = edge + (size_t)blk * 6 * FF + f;
        f32x4 p, a, q, g; const f32x4 z4 = (f32x4){0.f, 0.f, 0.f, 0.f};
        if (which == 0) { p = ((blk & 63) == 0) ? z4 : *(const f32x4*)(eb - 6 * FF + 3 * FF); a = *(const f32x4*)(eb); q = *(const f32x4*)(eb + FF); g = *(const f32x4*)(eb + 4 * FF); }
        else { p = *(const f32x4*)(eb + 2 * FF); a = *(const f32x4*)(eb + 3 * FF); q = ((blk & 63) == 63) ? z4 : *(const f32x4*)(eb + 6 * FF); g = *(const f32x4*)(eb + 5 * FF); }
        const f32x4 w0 = *(const f32x4*)(cw + f), w1 = *(const f32x4*)(cw + FF + f), w2 = *(const f32x4*)(cw + 2 * FF + f), bb = *(const f32x4*)(cb + f);
        const f32x4 v = bb + w0 * p + w1 * a + w2 * q;
        const int row = blk * 64 + (which ? 63 : 0);
        u32x2 w; w.x = pk_h2(pg8::gelu_tanh(v.x) * g.x, pg8::gelu_tanh(v.y) * g.y); w.y = pk_h2(pg8::gelu_tanh(v.z) * g.z, pg8::gelu_tanh(v.w) * g.w);
        *(u32x2*)(H + (size_t)row * FF + f) = w;
    }
}

__device__ __forceinline__ void attn_phase(LAS unsigned char* lds, const h16* QK, const h16* VT, const float* rpb, h16* AO, int G, int tid, int wid, int lane) {
    LAS unsigned char* Kl = lds + ATT_K_OFF; LAS unsigned char* Vl = lds + ATT_V_OFF; LAS float* Bl = (LAS float*)(lds + ATT_B_OFF);
    const int l15 = lane & 15, fq = lane >> 4;
    for (int uid = blockIdx.x; uid < BATCH * NH * 32; uid += G) {
        const int rp = uid & 31, h = (uid >> 5) & 15, b = uid >> 9;
        const int r0 = 2 * rp, ulo = clipi(r0 - 4, 0, 56), uhi = clipi(r0 - 3, 0, 56) + 7, nrows = uhi - ulo + 1;
        {
            const h16* kg = QK + (size_t)(b * SEQ + ulo * 64) * 2048 + 1024 + h * 64;
            const h16* vg = VT + (size_t)(h * 64) * M + b * SEQ + ulo * 64;
            u32x4 kv[9];
#pragma unroll
            for (int it = 0; it < 9; ++it) { const int c = tid + 512 * it, tok = c >> 3, ch = c & 7;
                if (tok < nrows * 64) kv[it] = *(const u32x4*)(kg + (size_t)tok * 2048 + ch * 8); }
            if (tid < 465) Bl[tid] = rpb[h * 465 + tid];
#pragma unroll
            for (int it = 0; it < 9; ++it) { const int c = tid + 512 * it, tok = c >> 3, ch = c & 7;
                if (tok < nrows * 64) *(LAS u32x4*)(Kl + tok * 128 + ((ch ^ ((tok >> 1) & 7)) * 16)) = kv[it]; }
            asm volatile("" ::: "memory");
#pragma unroll
            for (int it = 0; it < 9; ++it) { const int c = tid + 512 * it, d = c / 72, ch = c % 72;
                if (ch < nrows * 8) kv[it] = *(const u32x4*)(vg + (size_t)d * M + ch * 8); }
#pragma unroll
            for (int it = 0; it < 9; ++it) { const int c = tid + 512 * it, d = c / 72, ch = c % 72;
                if (ch < nrows * 8) { LAS u32x2* p = (LAS u32x2*)(Vl + d * ATT_VSTRIDE + ch * 16); p[0] = (u32x2){kv[it].x, kv[it].y}; p[1] = (u32x2){kv[it].z, kv[it].w}; } }
        }
        __syncthreads();
        {
            const int qr = r0 + (wid >> 2), qcb = wid & 3, rs = clipi(qr - 4, 0, 56), srow0 = rs - ulo;
            const int cq = qcb * 16 + l15, cs = clipi(cq - 8, 0, 48);
            const h16* qp = QK + (size_t)(b * SEQ + qr * 64 + cq) * 2048 + h * 64 + fq * 8;
            const h16x8 q0 = *(const h16x8*)qp, q1 = *(const h16x8*)(qp + 32);
            float mx = -INFINITY;
#pragma unroll
            for (int i = 0; i < 8; ++i) {
#pragma unroll
                for (int t = 0; t < 3; ++t) {
                    const int kcb = qcb - 1 + t;
                    if (kcb >= 0 && kcb <= 3) {
                        const int tok = (srow0 + i) * 64 + kcb * 16 + l15, sw = (tok >> 1) & 7;
                        const LAS unsigned char* kp = Kl + tok * 128;
                        const h16x8 k0 = *(const LAS h16x8*)(kp + ((fq ^ sw) * 16)), k1 = *(const LAS h16x8*)(kp + (((4 + fq) ^ sw) * 16));
                        f32x4 a = (f32x4){0.f, 0.f, 0.f, 0.f};
                        a = __builtin_amdgcn_mfma_f32_16x16x32_f16(k0, q0, a, 0, 0, 0);
                        a = __builtin_amdgcn_mfma_f32_16x16x32_f16(k1, q1, a, 0, 0, 0);
                        const LAS float* brow = Bl + (rs + i - qr + 7) * 31;
#pragma unroll
                        for (int j = 0; j < 4; ++j) { const int kc = kcb * 16 + 4 * fq + j; const bool ok = (kc >= cs) && (kc < cs + 16); const int dc = clipi(kc - cq + 15, 0, 30);
                            const float v = ok ? a[j] + brow[dc] : -INFINITY; mx = fmaxf(mx, v); }
                    }
                }
                asm volatile("" ::: "memory");
            }
            mx = fmaxf(mx, __shfl_xor(mx, 16)); mx = fmaxf(mx, __shfl_xor(mx, 32));
            const float mb = mx * 1.44269504089f; float sum = 0.f;
            f32x4 o[4];
#pragma unroll
            for (int db = 0; db < 4; ++db) o[db] = (f32x4){0.f, 0.f, 0.f, 0.f};
#pragma unroll
            for (int i2 = 0; i2 < 4; ++i2) {
#pragma unroll
                for (int t = 0; t < 3; ++t) {
                    const int kcb = qcb - 1 + t;
                    if (kcb >= 0 && kcb <= 3) {
                        h16x8 p;
#pragma unroll
                        for (int e = 0; e < 2; ++e) {
                            const int i = 2 * i2 + e;
                            const int tok = (srow0 + i) * 64 + kcb * 16 + l15, sw = (tok >> 1) & 7;
                            const LAS unsigned char* kp = Kl + tok * 128;
                            const h16x8 k0 = *(const LAS h16x8*)(kp + ((fq ^ sw) * 16)), k1 = *(const LAS h16x8*)(kp + (((4 + fq) ^ sw) * 16));
                            f32x4 a = (f32x4){0.f, 0.f, 0.f, 0.f};
                            a = __builtin_amdgcn_mfma_f32_16x16x32_f16(k0, q0, a, 0, 0, 0);
                            a = __builtin_amdgcn_mfma_f32_16x16x32_f16(k1, q1, a, 0, 0, 0);
                            const LAS float* brow = Bl + (rs + i - qr + 7) * 31;
#pragma unroll
                            for (int j = 0; j < 4; ++j) { const int kc = kcb * 16 + 4 * fq + j; const bool ok = (kc >= cs) && (kc < cs + 16); const int dc = clipi(kc - cq + 15, 0, 30);
                                const float v = ok ? a[j] + brow[dc] : -INFINITY; const float pe = __builtin_amdgcn_exp2f(v * 1.44269504089f - mb); sum += pe; p[4 * e + j] = (h16)pe; }
                        }
                        const int tok0 = (srow0 + 2 * i2) * 64 + kcb * 16 + 4 * fq;
#pragma unroll
                        for (int db = 0; db < 4; ++db) {
                            const LAS unsigned char* vp = Vl + (db * 16 + l15) * ATT_VSTRIDE + tok0 * 2;
                            const u32x2 lo = *(const LAS u32x2*)vp, hi = *(const LAS u32x2*)(vp + 128);
                            const u32x4 vw = (u32x4){lo.x, lo.y, hi.x, hi.y};
                            o[db] = __builtin_amdgcn_mfma_f32_16x16x32_f16(__builtin_bit_cast(h16x8, vw), p, o[db], 0, 0, 0);
                        }
                    }
                    asm volatile("" ::: "memory");
                }
            }
            sum += __shfl_xor(sum, 16); sum += __shfl_xor(sum, 32);
            const float inv = 1.0f / sum;
            h16* op = AO + (size_t)(b * SEQ + qr * 64 + cq) * D + h * 64 + 4 * fq;
#pragma unroll
            for (int db = 0; db < 4; ++db) { const f32x4 v = o[db] * inv; u32x2 w; w.x = pk_h2(v.x, v.y); w.y = pk_h2(v.z, v.w); *(u32x2*)(op + db * 16) = w; }
        }
        __syncthreads();
    }
}

__global__ void __launch_bounds__(NWAVES * 64, 2) mega_fwd(Args args) {
    extern __shared__ __attribute__((aligned(16))) unsigned char lds_raw[];
    LAS unsigned char* lds = (LAS unsigned char*)lds_raw;
    cg::grid_group grid = cg::this_grid();
    const int tid = threadIdx.x, lane = tid & 63, wid = __builtin_amdgcn_readfirstlane(tid >> 6);
    const int G = gridDim.x;
    unsigned char* ws = args.ws;
    const float* x = args.in[0]; const float* cvec = args.in[1]; const float* ada_w = args.in[2]; const float* ada_b = args.in[3];
    const float* w_qkv = args.in[4]; const float* rpb = args.in[5]; const float* na_wo = args.in[6]; const float* fn_wo = args.in[7];
    const float* ln1_g = args.in[8]; const float* ln1_b = args.in[9]; const float* w_up = args.in[10]; const float* conv_w = args.in[11];
    const float* conv_b = args.in[12]; const float* w_down = args.in[13]; const float* ln2_g = args.in[14]; const float* ln2_b = args.in[15];
    float* out = args.out;
    float* mod = (float*)(ws + WS_MOD); float* stats = (float*)(ws + WS_STATS);
    h16* DFT128 = (h16*)(ws + WS_DFT128);
    h16* Wqk_t = (h16*)(ws + WS_WQK); h16* Wv_t = (h16*)(ws + WS_WV); h16* Wo_t = (h16*)(ws + WS_WO); h16* Fwo_t = (h16*)(ws + WS_FWO);
    h16* Wup0 = (h16*)(ws + WS_WUP0); h16* Wup1 = (h16*)(ws + WS_WUP1); h16* Wdn0 = (h16*)(ws + WS_WDN0); h16* Wdn1 = (h16*)(ws + WS_WDN1);
    float* edge = (float*)(ws + WS_EDGE);
    h16* U = (h16*)(ws + WS_U); float* ZA = (float*)(ws + WS_ZA);
    h16* QKb = (h16*)(ws + WS_QK); h16* VTb = (h16*)(ws + WS_VT); h16* Hb = (h16*)(ws + WS_H); h16* PQT = (h16*)(ws + WS_PQT); h16* Fm = (h16*)(ws + WS_F);

    const int lo = args.ph_lo, hi = args.ph_hi;
#define IN(k) (lo <= (k) && (k) < hi)
#define SEAM(k) do { if (IN(k) && IN((k) + 1)) grid.sync(); } while (0)
    const size_t T1K = (size_t)256 * 1024 * 2;

    if (IN(0)) {
        LAS float* scr = (LAS float*)(lds + wid * 8448);
        const int gw = blockIdx.x * NWAVES + wid, NGW = G * NWAVES;
        constexpr int I_QK = 16 * 64, I_V = 16 * 32, I_O = 16 * 32, I_UP = 16 * 176, I_DN = 44 * 32;
        constexpr int NITEMS = I_QK + I_V + 2 * I_O + 2 * I_UP + 2 * I_DN;
        for (int it = gw; it < NITEMS; it += NGW) {
            int r = it;
            if (r < I_QK) { p0_transpose_item<0>(w_qkv, 3072, 0, 1024, 2048, Wqk_t, scr, r, lane); continue; } r -= I_QK;
            if (r < I_V) { p0_transpose_item<0>(w_qkv, 3072, 2048, 1024, 1024, Wv_t, scr, r, lane); continue; } r -= I_V;
            if (r < I_O) { p0_transpose_item<0>(na_wo, 1024, 0, 1024, 1024, Wo_t, scr, r, lane); continue; } r -= I_O;
            if (r < I_O) { p0_transpose_item<0>(fn_wo, 1024, 0, 1024, 1024, Fwo_t, scr, r, lane); continue; } r -= I_O;
            if (r < I_UP) { p0_transpose_item<1>(w_up, 5632, 0, 1024, 5632, Wup0, scr, r, lane); continue; } r -= I_UP;
            if (r < I_UP) { p0_transpose_item<1>(w_up + (size_t)1024 * 5632, 5632, 0, 1024, 5632, Wup1, scr, r, lane); continue; } r -= I_UP;
            if (r < I_DN) { p0_transpose_item<0>(w_down, 1024, 0, 2816, 1024, Wdn0, scr, r, lane); continue; } r -= I_DN;
            p0_transpose_item<0>(w_down + (size_t)2816 * 1024, 1024, 0, 2816, 1024, Wdn1, scr, r, lane);
        }
        for (int e = blockIdx.x * 512 + tid; e < 256 * 128; e += G * 512) {
            const int row = e >> 7, c = e & 127, ri = row >> 7, m = row & 127; const float ph = (float)((m * c) & 127) * (1.0f / 128.0f);
            const float v = (ri ? -__builtin_amdgcn_sinf(ph) : __builtin_amdgcn_cosf(ph)) * 0.08838834764831845f;
            DFT128[e] = (h16)v;
        }
        __syncthreads();
        LAS float* cs = (LAS float*)(lds + 80 * 1024);
        LAS float* red = (LAS float*)(lds + 112 * 1024);
        if (blockIdx.x < 192) {
            for (int i = tid; i < 8 * 1024; i += 512) { const float v = cvec[i]; cs[i] = v / (1.0f + __expf(-v)); }
            __syncthreads();
            for (int it = blockIdx.x; it < 192; it += G) {
                const int li = it / 96, e0 = (it % 96) * 64;
                const float* wp = ada_w + (size_t)li * 1024 * 6144 + (size_t)(wid * 128) * 6144 + e0 + lane;
                float a[8];
#pragma unroll
                for (int b = 0; b < 8; ++b) a[b] = 0.f;
#pragma unroll 8
                for (int d = 0; d < 128; ++d) { const float w = wp[(size_t)d * 6144];
#pragma unroll
                    for (int b = 0; b < 8; ++b) a[b] += w * cs[b * 1024 + wid * 128 + d]; }
#pragma unroll
                for (int b = 0; b < 8; ++b) red[(wid * 8 + b) * 64 + lane] = a[b];
                __syncthreads();
                { const int b = tid >> 6, col = tid & 63; float s = ada_b[li * 6144 + e0 + col];
#pragma unroll
                  for (int w = 0; w < 8; ++w) s += red[(w * 8 + b) * 64 + col];
                  mod[(size_t)(li * 8 + b) * 6144 + e0 + col] = s; }
                __syncthreads();
            }
        }
    }
    SEAM(0);
    const float* mod0 = mod; const float* mod1 = mod + 8 * 6144;

    if (IN(1)) ln_rows<0>(x, nullptr, nullptr, mod0 + 0 * 1024, mod0 + 1 * 1024, U, nullptr, nullptr, G, wid, lane);
    SEAM(1);
    if (IN(2)) {
        { pg8::Gemm g{U, Wqk_t, 1024, 1024, 1024, T1K, T1K, 0}; pg8::StaticOrder S; S.init(M, 2048, G, (int)blockIdx.x);
          pg8::EpiH16 E{QKb, 2048, 0, 0, 1024, 0.125f};
          pg8::gemm_phase<pg8::EpiH16, pg8::StaticOrder, true, true>(lds, g, S, E); }
        { pg8::Gemm g{Wv_t, U, 1024, 1024, 1024, T1K, T1K, 0}; pg8::StaticOrder S; S.init(1024, M, G, (int)blockIdx.x);
          pg8::EpiH16 E{VTb, M, 0, 0, 0, 1.f};
          pg8::gemm_phase<pg8::EpiH16, pg8::StaticOrder, true, true>(lds, g, S, E); }
    }
    SEAM(2);
    if (IN(3)) attn_phase(lds, QKb, VTb, rpb, U, G, tid, wid, lane);
    SEAM(3);
    if (IN(4)) { pg8::Gemm g{U, Wo_t, 1024, 1024, 1024, T1K, T1K, 0}; pg8::StaticOrder S; S.init(M, 1024, G, (int)blockIdx.x);
        pg8::EpiRes E{x, nullptr, nullptr, nullptr, mod0 + 2 * 1024, ZA};
        pg8::gemm_phase<pg8::EpiRes, pg8::StaticOrder, true, true>(lds, g, S, E); }
    SEAM(4);
#pragma unroll
    for (int L = 0; L < 2; ++L) {
        const int pb = (L == 0) ? 5 : 13;
        const float* modL = L ? mod1 : mod0;
        if (IN(pb)) ln_rows<1>(ZA, ln1_g + L * 1024, ln1_b + L * 1024, modL + 3 * 1024, modL + 4 * 1024, U, stats, nullptr, G, wid, lane);
        SEAM(pb);
        if (IN(pb + 1)) { pg8::Gemm g{U, L ? Wup1 : Wup0, 1024, 1024, 1024, T1K, T1K, 0}; pg8::StaticOrder S; S.init(M, 2 * FF, G, (int)blockIdx.x);
            pg8::EpiUp E{conv_w + (size_t)L * 3 * FF, conv_b + L * FF, Hb, edge};
            pg8::gemm_phase<pg8::EpiUp, pg8::StaticOrder, true, true>(lds, g, S, E); }
        SEAM(pb + 1);
        if (IN(pb + 2)) ffn_fixup(edge, conv_w + (size_t)L * 3 * FF, conv_b + L * FF, Hb, G);
        SEAM(pb + 2);
        if (IN(pb + 3)) { pg8::Gemm g{Hb, L ? Wdn1 : Wdn0, FF, FF, FF, (size_t)256 * FF * 2, (size_t)256 * FF * 2, 0}; pg8::StaticOrder S; S.init(M, 1024, G, (int)blockIdx.x);
            pg8::EpiRes E{ZA, stats, ln1_g + L * 1024, ln1_b + L * 1024, modL + 5 * 1024, out};
            pg8::gemm_phase<pg8::EpiRes, pg8::StaticOrder, true, true>(lds, g, S, E); }
        SEAM(pb + 3);
        if (L == 0) {
            if (IN(9)) {
                ln_rows<1>(out, ln2_g, ln2_b, mod1 + 0 * 1024, mod1 + 1 * 1024, U, stats, nullptr, G, wid, lane);
                for (int it = blockIdx.x * 512 + tid; it < 4096 * 1024; it += G * 512) {
                    const int k = it >> 10, c8 = it & 1023, ri = c8 >> 9, s0 = (c8 & 511) * 8;
                    float v[8];
#pragma unroll
                    for (int j = 0; j < 8; ++j) { const float ph = (float)((k * (s0 + j)) & 4095) * (1.0f / 4096.0f); v[j] = (ri ? __builtin_amdgcn_sinf(ph) : __builtin_amdgcn_cosf(ph)) * (1.0f / 64.0f); }
                    u32x4 w; w.x = pk_h2(v[0], v[1]); w.y = pk_h2(v[2], v[3]); w.z = pk_h2(v[4], v[5]); w.w = pk_h2(v[6], v[7]);
                    *(u32x4*)(Fm + (size_t)k * 8192 + ri * 4096 + s0) = w;
                }
            }
            SEAM(9);
            if (IN(10)) { int k128 = 128; asm volatile("" : "+s"(k128)); pg8::Gemm g{DFT128, U, 128, 1024, k128, 0, T1K, 256}; pg8::StaticOrder S; S.init(8 * 256, M, G, (int)blockIdx.x);
                pg8::EpiF1 E{PQT};
                pg8::gemm_phase<pg8::EpiF1, pg8::StaticOrder, true, true>(lds, g, S, E); }
            SEAM(10);
            if (IN(11)) { pg8::Gemm g{Fm, PQT, 8192, 8192, 8192, (size_t)256 * 8192 * 2, (size_t)256 * 8192 * 2, 0}; pg8::StaticOrder S; S.init(4096, 8192, G, (int)blockIdx.x);
                pg8::EpiH16 E{U, 1024, 1024, (size_t)4096 * 1024, 0, 1.f};
                pg8::gemm_phase<pg8::EpiH16, pg8::StaticOrder, true, true>(lds, g, S, E); }
            SEAM(11);
            if (IN(12)) { pg8::Gemm g{U, Fwo_t, 1024, 1024, 1024, T1K, T1K, 0}; pg8::StaticOrder S; S.init(M, 1024, G, (int)blockIdx.x);
                pg8::EpiRes E{out, stats, ln2_g, ln2_b, mod1 + 2 * 1024, ZA};
                pg8::gemm_phase<pg8::EpiRes, pg8::StaticOrder, true, true>(lds, g, S, E); }
            SEAM(12);
        }
    }
    if (IN(17)) ln_rows<2>(out, ln2_g + 1024, ln2_b + 1024, nullptr, nullptr, nullptr, nullptr, out, G, wid, lane);
#undef IN
#undef SEAM
}

extern "C" void kernel_launch(void* const* d_in, const int* in_sizes, int n_in, void* d_out, int out_size, void* d_ws, size_t ws_size, hipStream_t stream) {
    static int grid = 0;
    if (grid == 0) {
        if (n_in != 16 || out_size != M * D || ws_size < WS_END) { fprintf(stderr, "kernel_launch: unexpected shapes (n_in %d out %d ws %zu)\n", n_in, out_size, ws_size); grid = -1; return; }
        int dev = 0, cus = 0, per_cu = 0;
        hipGetDevice(&dev); hipDeviceGetAttribute(&cus, hipDeviceAttributeMultiprocessorCount, dev);
        if (hipFuncSetAttribute((const void*)mega_fwd, hipFuncAttributeMaxDynamicSharedMemorySize, LDS_BYTES) != hipSuccess) { fprintf(stderr, "kernel_launch: hipFuncSetAttribute failed\n"); grid = -1; return; }
        if (hipOccupancyMaxActiveBlocksPerMultiprocessor(&per_cu, (const void*)mega_fwd, NWAVES * 64, LDS_BYTES) != hipSuccess || per_cu < 1) { fprintf(stderr, "kernel_launch: occupancy query says %d\n", per_cu); per_cu = 1; }
        (void)hipGetLastError();
        grid = cus;
        fprintf(stderr, "kernel_launch: grid %d (cus %d, per_cu %d)\n", grid, cus, per_cu);
    }
    if (grid < 0) return;
    Args a{};
    for (int i = 0; i < 16; ++i) a.in[i] = (const float*)d_in[i];
    a.out = (float*)d_out; a.ws = (unsigned char*)d_ws;
#if MK_ONE_LAUNCH
    a.ph_lo = 0; a.ph_hi = N_PHASES; a.coop = 1;
    void* kargs[] = {&a};
    hipError_t e = hipLaunchCooperativeKernel((const void*)mega_fwd, dim3(grid), dim3(NWAVES * 64), kargs, LDS_BYTES, stream);
    if (e != hipSuccess) fprintf(stderr, "cooperative launch failed: %s (grid %d)\n", hipGetErrorString(e), grid);
#else
    for (int p = 0; p < N_PHASES; ++p) { a.ph_lo = p; a.ph_hi = p + 1; a.coop = 0;
        hipLaunchKernelGGL(mega_fwd, dim3(grid), dim3(NWAVES * 64), LDS_BYTES, stream, a); }
#endif
}
```

```cpp
#include <hip/hip_runtime.h>
#include <hip/hip_cooperative_groups.h>
#include <cstdio>
#include <cstdint>
namespace cg = cooperative_groups;

#ifndef MK_ONE_LAUNCH
#define MK_ONE_LAUNCH 1
#endif

namespace pg8 {
#define PG8_LAS __attribute__((address_space(3)))
typedef _Float16 h16;
typedef _Float16 h16x8 __attribute__((ext_vector_type(8)));
typedef _Float16 h16x2 __attribute__((ext_vector_type(2)));
typedef float f32x4 __attribute__((ext_vector_type(4)));
typedef float f32x2 __attribute__((ext_vector_type(2)));
typedef unsigned u32x4 __attribute__((ext_vector_type(4)));
typedef unsigned u32x2 __attribute__((ext_vector_type(2)));
constexpr int BM = 256, BK = 64, HALF = 128, HTB = HALF * BK * 2  , STAGE_BYTES = 8 * HTB, NXCD = 8, WGM = 8;

__host__ __device__ __forceinline__ int lds_byte(int r, int c) { const int st = (r >> 4) * 2 + (c >> 5), rr = r & 15, cc = c & 31, ob = rr * 64 + cc * 2; return st * 1024 + (ob ^ (((ob >> 9) & 1) << 5)); }
__host__ __device__ __forceinline__ void stage_rc(int b, int& R, int& C) { const int st = b / 1024, sb = b % 1024, swz = sb ^ (((sb >> 9) & 1) << 5); R = (st >> 1) * 16 + swz / 64; C = (st & 1) * 32 + (swz % 64) / 2; }
__host__ __device__ __forceinline__ int perm32(int rho) { const int n = rho >> 4, i = rho & 15; return 8 * (i >> 2) + 4 * n + (i & 3); }

struct Unit { int pm, pn; };
struct Gemm { const h16* A; const h16* Bt; int lda, ldb, K; size_t a_tile, b_tile, b_pm_koff; };

struct StaticOrder {
    int nM, nN, nwg, G, c;
    __host__ __device__ void init(int M, int N, int G_, int c_) { nM = M / BM; nN = N / BM; nwg = nM * nN; G = G_; c = c_; }
    __host__ __device__ bool next(int i, Unit& u) const {
        const long L = (long)i * G + c; if (L >= nwg) return false;
        int wgid = (int)L; { const int q = nwg / NXCD, r = nwg % NXCD, xcd = wgid % NXCD, off = wgid / NXCD; wgid = (xcd < r ? xcd * (q + 1) : r * (q + 1) + (xcd - r) * q) + off; }
        const int nig = WGM * nN, gid = wgid / nig, fm = gid * WGM, gsz = (nM - fm) < WGM ? (nM - fm) : WGM;
        u.pm = fm + ((wgid % nig) % gsz); u.pn = (wgid % nig) / gsz; return true;
    }
    __device__ __forceinline__ void a_ready(const Unit&) const {}
    __device__ __forceinline__ void done(const Unit&) const {}
};

__device__ __forceinline__ unsigned pk_h2(float lo, float hi) { h16x2 v; v.x = (h16)lo; v.y = (h16)hi; return __builtin_bit_cast(unsigned, v); }


struct EpiH16 {
    static constexpr bool PERM = true, AFTER_DRAIN = false;
    h16* O; int ldc; int split_cols; size_t split_stride; int scale_cols; float scale;
    __device__ __forceinline__ void operator()(const f32x4 (&acc)[2][2][4][2], const Unit& u, int wr, int wc, int fr, int fq) const {
        const int row0 = u.pm * BM + wr * 64 + fr; int colt = u.pn * BM; h16* base = O;
        const float sc = (colt < scale_cols) ? scale : 1.f;
        if (split_cols) { const int t = colt / split_cols; base += (size_t)t * split_stride; colt -= t * split_cols; }
        const int col0 = colt + wc * 32 + 8 * fq;
#pragma unroll
        for (int ai = 0; ai < 2; ++ai)
#pragma unroll
            for (int m = 0; m < 4; ++m) { h16* rowp = base + (size_t)(row0 + ai * HALF + m * 16) * ldc + col0;
#pragma unroll
                for (int bj = 0; bj < 2; ++bj) { const f32x4 v0 = acc[ai][bj][m][0] * sc, v1 = acc[ai][bj][m][1] * sc;
                    u32x4 w; w.x = pk_h2(v0[0], v0[1]); w.y = pk_h2(v0[2], v0[3]); w.z = pk_h2(v1[0], v1[1]); w.w = pk_h2(v1[2], v1[3]);
                    *(u32x4*)(rowp + bj * HALF) = w; } }
    }
};

struct EpiF1 {
    static constexpr bool PERM = true, AFTER_DRAIN = false;
    h16* PQT;
    __device__ __forceinline__ void operator()(const f32x4 (&acc)[2][2][4][2], const Unit& u, int wr, int wc, int fr, int fq) const {
        const int b = u.pn >> 4, s0 = (u.pn & 15) * 256 + wc * 32 + 8 * fq;
#pragma unroll
        for (int ai = 0; ai < 2; ++ai)
#pragma unroll
            for (int m = 0; m < 4; ++m) { h16* rowp = PQT + (size_t)(b * 1024 + u.pm * 128 + wr * 64 + m * 16 + fr) * 8192 + ai * 4096 + s0;
#pragma unroll
                for (int bj = 0; bj < 2; ++bj) { const f32x4 v0 = acc[ai][bj][m][0], v1 = acc[ai][bj][m][1];
                    u32x4 w; w.x = pk_h2(v0[0], v0[1]); w.y = pk_h2(v0[2], v0[3]); w.z = pk_h2(v1[0], v1[1]); w.w = pk_h2(v1[2], v1[3]);
                    *(u32x4*)(rowp + bj * HALF) = w; } }
    }
};

struct EpiRes {
    static constexpr bool PERM = false, AFTER_DRAIN = false;
    const float* res; const float* stats; const float* gam; const float* bet; const float* gate; float* out;
    __device__ __forceinline__ void operator()(const f32x4 (&acc)[2][2][4][2], const Unit& u, int wr, int wc, int fr, int fq) const {
        const int b = u.pm >> 4; const float ALPHA = 1.41421356237f;
#pragma unroll
        for (int bj = 0; bj < 2; ++bj)
#pragma unroll
            for (int n = 0; n < 2; ++n) {
                const int col = u.pn * BM + bj * HALF + wc * 32 + n * 16 + 4 * fq;
                const f32x4 gt = *(const f32x4*)(gate + b * 6144 + col) + 1.0f;
                f32x4 gm = (f32x4){1.f, 1.f, 1.f, 1.f}, bt = (f32x4){0.f, 0.f, 0.f, 0.f};
                if (stats) { gm = *(const f32x4*)(gam + col); bt = *(const f32x4*)(bet + col); }
#pragma unroll
                for (int ai = 0; ai < 2; ++ai)
#pragma unroll
                    for (int m = 0; m < 4; ++m) {
                        const int row = u.pm * BM + ai * HALF + wr * 64 + m * 16 + fr;
                        f32x4 r = *(const f32x4*)(res + (size_t)row * 1024 + col);
                        if (stats) { const f32x2 st = *(const f32x2*)(stats + 2 * row); r = (r - st.x) * st.y * gm + bt; }
                        const f32x4 o = r * ALPHA + gt * acc[ai][bj][m][n];
                        *(f32x4*)(out + (size_t)row * 1024 + col) = o;
                    }
            }
    }
};

__device__ __forceinline__ float dpp_prev(float old, float src) {
    return __builtin_bit_cast(float, __builtin_amdgcn_update_dpp(__builtin_bit_cast(int, old), __builtin_bit_cast(int, src), 0x111, 0xf, 0xf, false)); }
__device__ __forceinline__ float dpp_next(float old, float src) {
    return __builtin_bit_cast(float, __builtin_amdgcn_update_dpp(__builtin_bit_cast(int, old), __builtin_bit_cast(int, src), 0x101, 0xf, 0xf, false)); }
__device__ __forceinline__ float dpp_ror1(float src) {
    return __builtin_bit_cast(float, __builtin_amdgcn_update_dpp(0, __builtin_bit_cast(int, src), 0x121, 0xf, 0xf, false)); }
__device__ __forceinline__ float dpp_ror15(float src) {
    return __builtin_bit_cast(float, __builtin_amdgcn_update_dpp(0, __builtin_bit_cast(int, src), 0x12f, 0xf, 0xf, false)); }
__device__ __forceinline__ float gelu_tanh(float v) {
    const float y = v + 0.044715f * v * v * v;
    const float e = __builtin_amdgcn_exp2f(-2.302208198f * y);
    return v * __builtin_amdgcn_rcpf(1.0f + e);
}

struct EpiUp {
    static constexpr bool PERM = true, AFTER_DRAIN = false;
    const float* cw; const float* cb; h16* H; float* edge;
    __device__ __forceinline__ void operator()(const f32x4 (&acc)[2][2][4][2], const Unit& u, int wr, int wc, int fr, int fq) const {
        const int f0 = u.pn * 128 + wc * 32 + 8 * fq;
        f32x4 w0[2], w1[2], w2[2], bb[2];
#pragma unroll
        for (int n = 0; n < 2; ++n) { w0[n] = *(const f32x4*)(cw + f0 + 4 * n); w1[n] = *(const f32x4*)(cw + 2816 + f0 + 4 * n); w2[n] = *(const f32x4*)(cw + 2 * 2816 + f0 + 4 * n); bb[n] = *(const f32x4*)(cb + f0 + 4 * n); }
#pragma unroll
        for (int ai = 0; ai < 2; ++ai) {
            const int blk = u.pm * 4 + ai * 2 + wr;
            float* eb = edge + (size_t)blk * 6 * 2816 + f0;
#pragma unroll
            for (int m = 0; m < 4; ++m) {
                unsigned pk[4];
#pragma unroll
                for (int n = 0; n < 2; ++n) {
                    const f32x4 a = acc[ai][0][m][n], g = acc[ai][1][m][n];
                    f32x4 hv;
#pragma unroll
                    for (int j = 0; j < 4; ++j) {
                        const float po = (m > 0) ? dpp_ror1(acc[ai][0][m > 0 ? m - 1 : 0][n][j]) : 0.f;
                        const float no = (m < 3) ? dpp_ror15(acc[ai][0][m < 3 ? m + 1 : 3][n][j]) : 0.f;
                        const float p = dpp_prev(po, a[j]), q = dpp_next(no, a[j]);
                        const float v = bb[n][j] + w0[n][j] * p + w1[n][j] * a[j] + w2[n][j] * q;
                        hv[j] = gelu_tanh(v) * g[j];
                    }
                    pk[2 * n] = pk_h2(hv[0], hv[1]); pk[2 * n + 1] = pk_h2(hv[2], hv[3]);
                    if (m == 0) { if (fr == 0) { *(f32x4*)(eb + 0 * 2816 + 4 * n) = a; *(f32x4*)(eb + 4 * 2816 + 4 * n) = g; } if (fr == 1) *(f32x4*)(eb + 1 * 2816 + 4 * n) = a; }
                    if (m == 3) { if (fr == 14) *(f32x4*)(eb + 2 * 2816 + 4 * n) = a; if (fr == 15) { *(f32x4*)(eb + 3 * 2816 + 4 * n) = a; *(f32x4*)(eb + 5 * 2816 + 4 * n) = g; } }
                }
                const int row = u.pm * BM + ai * HALF + wr * 64 + m * 16 + fr;
                u32x4 w; w.x = pk[0]; w.y = pk[1]; w.z = pk[2]; w.w = pk[3];
                *(u32x4*)(H + (size_t)row * 2816 + f0) = w;
            }
        }
    }
};

template <class Epi, class Sched, bool ALIGN_EPI = false, bool SP2 = false>
__device__ __forceinline__ void gemm_phase(PG8_LAS unsigned char* lds, const Gemm g, const Sched& S, const Epi& E) {
    int tid_ = threadIdx.x; asm volatile("" : "+v"(tid_));
    const int tid = tid_, wid = __builtin_amdgcn_readfirstlane(tid >> 6), lane = tid & 63, wr = wid >> 2, wc = wid & 3, fr = lane & 15, fq = lane >> 4;
    const int K = g.K, nt = K / BK;
    unsigned voffA[2], voffB[2];
#pragma unroll
    for (int i = 0; i < 2; ++i) { int R, C; stage_rc(tid * 16 + i * 8192, R, C); const int Rb = Epi::PERM ? ((R & ~31) + perm32(R & 31)) : R;
        voffA[i] = (unsigned)(R * g.lda + C) * 2u; voffB[i] = (unsigned)(Rb * g.ldb + C) * 2u; }
    const size_t kstep = (size_t)(BK * 2);
    const size_t hstepA = (size_t)HALF * g.lda * 2, hstepB = (size_t)HALF * g.ldb * 2;
    const unsigned ldsw = (unsigned)wid * 1024u;
    const int aoff = lds_byte(wr * 64 + fr, fq * 8), boff = lds_byte(wc * 32 + fr, fq * 8);
#define PG8_SA(b, h) (((b) * 2 + (h)) * HTB)
#define PG8_SB(b, h) ((4 + (b) * 2 + (h)) * HTB)
#define PG8_STAGE(bufoff, gbase, voff) do { _Pragma("unroll") for (int _i = 0; _i < 2; ++_i) \
        __builtin_amdgcn_global_load_lds((const unsigned*)((const char*)(gbase) + (voff)[_i]), (PG8_LAS unsigned*)(lds + (bufoff) + ldsw + _i * 8192), 16, 0, 0); } while (0)
#define PG8_LDA(dst, b, h) do { _Pragma("unroll") for (int m = 0; m < 4; ++m) _Pragma("unroll") for (int k = 0; k < 2; ++k) dst[m][k] = *(const PG8_LAS h16x8*)(lds + PG8_SA(b, h) + aoff + m * 2048 + k * 1024); } while (0)
#define PG8_LDB(dst, b, h) do { _Pragma("unroll") for (int n = 0; n < 2; ++n) _Pragma("unroll") for (int k = 0; k < 2; ++k) dst[n][k] = *(const PG8_LAS h16x8*)(lds + PG8_SB(b, h) + boff + n * 2048 + k * 1024); } while (0)
#define PG8_MMA(ai, bj, At, Bt) do { __builtin_amdgcn_s_setprio(1); _Pragma("unroll") for (int m = 0; m < 4; ++m) _Pragma("unroll") for (int n = 0; n < 2; ++n) _Pragma("unroll") for (int k = 0; k < 2; ++k) \
        acc[ai][bj][m][n] = __builtin_amdgcn_mfma_f32_16x16x32_f16(Bt[n][k], At[m][k], acc[ai][bj][m][n], 0, 0, 0); __builtin_amdgcn_s_setprio(0); } while (0)
#define PG8_WAIT_V(n) asm volatile("s_waitcnt vmcnt(" #n ")" ::: "memory")
#define PG8_WAIT_L(n) asm volatile("s_waitcnt lgkmcnt(" #n ")" ::: "memory")
#define PG8_BAR __builtin_amdgcn_s_barrier()
#define PG8_SCHED __builtin_amdgcn_sched_barrier(0)
    Unit cur, nxt; int ui = 0;
    if (!S.next(0, cur)) return;
    f32x4 acc[2][2][4][2];
#pragma unroll
    for (int a = 0; a < 2; ++a)
#pragma unroll
        for (int b = 0; b < 2; ++b)
#pragma unroll
            for (int m = 0; m < 4; ++m)
#pragma unroll
                for (int n = 0; n < 2; ++n) acc[a][b][m][n] = (f32x4){0.f, 0.f, 0.f, 0.f};
    h16x8 At[4][2], B0[2][2], B1[2][2];
    const char* cA = (const char*)g.A + (size_t)cur.pm * g.a_tile; const char* cB = (const char*)g.Bt + (size_t)cur.pn * g.b_tile + (size_t)cur.pm * g.b_pm_koff;
    S.a_ready(cur);
    if constexpr (SP2) {
        PG8_STAGE(PG8_SB(0, 0), cB, voffB); PG8_STAGE(PG8_SB(0, 1), cB + hstepB, voffB); PG8_STAGE(PG8_SA(0, 0), cA, voffA); PG8_STAGE(PG8_SA(0, 1), cA + hstepA, voffA);
        if (wr == 1) PG8_BAR;
        PG8_WAIT_V(2); PG8_BAR;
        PG8_STAGE(PG8_SB(1, 0), cB + kstep, voffB); PG8_STAGE(PG8_SA(1, 0), cA + kstep, voffA); PG8_STAGE(PG8_SB(1, 1), cB + hstepB + kstep, voffB);
        PG8_WAIT_V(6); PG8_BAR;
    } else {
        PG8_STAGE(PG8_SB(0, 0), cB, voffB); PG8_STAGE(PG8_SA(0, 0), cA, voffA); PG8_STAGE(PG8_SB(0, 1), cB + hstepB, voffB); PG8_STAGE(PG8_SA(0, 1), cA + hstepA, voffA);
        if (wr == 1) PG8_BAR;
        PG8_WAIT_V(4); PG8_BAR;
        PG8_STAGE(PG8_SB(1, 0), cB + kstep, voffB); PG8_STAGE(PG8_SA(1, 0), cA + kstep, voffA); PG8_STAGE(PG8_SB(1, 1), cB + hstepB + kstep, voffB);
        PG8_WAIT_V(6); PG8_BAR;
    }
    for (;;) {
        const bool has_next = S.next(ui + 1, nxt);
        const char* nA = has_next ? (const char*)g.A + (size_t)nxt.pm * g.a_tile : cA; const char* nB = has_next ? (const char*)g.Bt + (size_t)nxt.pn * g.b_tile + (size_t)nxt.pm * g.b_pm_koff : cB;
        for (int t = 0; t < nt; t += 2) {
            const bool last = (t == nt - 2);
            const char* a1 = cA + (size_t)(t + 1) * kstep;
            const char* a2 = last ? nA : cA + (size_t)(t + 2) * kstep; const char* b2 = last ? nB : cB + (size_t)(t + 2) * kstep;
            const char* a3 = a2 + kstep; const char* b3 = b2 + kstep;
            if (last && has_next) S.a_ready(nxt);
            if constexpr (SP2) {
            PG8_LDB(B0, 0, 0); PG8_LDB(B1, 0, 1); PG8_SCHED; PG8_LDA(At, 0, 0); PG8_STAGE(PG8_SA(1, 1), a1 + hstepA, voffA);
            PG8_WAIT_V(8); PG8_WAIT_L(0); PG8_BAR; PG8_MMA(0, 0, At, B0); PG8_MMA(0, 1, At, B1); PG8_BAR; PG8_SCHED;
            PG8_LDA(At, 0, 1); PG8_STAGE(PG8_SB(0, 0), b2, voffB); PG8_STAGE(PG8_SB(0, 1), b2 + hstepB, voffB); PG8_STAGE(PG8_SA(0, 0), a2, voffA);
            PG8_WAIT_V(8); PG8_WAIT_L(0); PG8_BAR; PG8_MMA(1, 0, At, B0); PG8_MMA(1, 1, At, B1); PG8_BAR; PG8_SCHED;
            PG8_LDB(B0, 1, 0); PG8_LDB(B1, 1, 1); PG8_SCHED; PG8_LDA(At, 1, 0); PG8_STAGE(PG8_SA(0, 1), a2 + hstepA, voffA);
            PG8_WAIT_V(8); PG8_WAIT_L(0); PG8_BAR; PG8_MMA(0, 0, At, B0); PG8_MMA(0, 1, At, B1); PG8_BAR; PG8_SCHED;
            PG8_LDA(At, 1, 1); PG8_STAGE(PG8_SB(1, 0), b3, voffB); PG8_STAGE(PG8_SB(1, 1), b3 + hstepB, voffB); PG8_STAGE(PG8_SA(1, 0), a3, voffA);
            PG8_WAIT_V(8); PG8_WAIT_L(0); PG8_BAR; PG8_MMA(1, 0, At, B0); PG8_MMA(1, 1, At, B1); PG8_BAR; PG8_SCHED;
            } else {
            PG8_LDB(B0, 0, 0); PG8_SCHED; PG8_LDA(At, 0, 0); PG8_STAGE(PG8_SA(1, 1), a1 + hstepA, voffA);
            PG8_WAIT_L(8); PG8_BAR; PG8_WAIT_L(0); PG8_MMA(0, 0, At, B0); PG8_BAR; PG8_SCHED;
            PG8_LDB(B1, 0, 1); PG8_STAGE(PG8_SB(0, 0), b2, voffB);
            PG8_BAR; PG8_WAIT_L(0); PG8_MMA(0, 1, At, B1); PG8_BAR;
            PG8_LDA(At, 0, 1); PG8_STAGE(PG8_SA(0, 0), a2, voffA);
            PG8_BAR; PG8_WAIT_L(0); PG8_MMA(1, 0, At, B0); PG8_BAR; PG8_SCHED;
            PG8_STAGE(PG8_SB(0, 1), b2 + hstepB, voffB);
            PG8_WAIT_V(6); PG8_BAR; PG8_MMA(1, 1, At, B1); PG8_BAR;
            PG8_LDB(B0, 1, 0); PG8_SCHED; PG8_LDA(At, 1, 0); PG8_STAGE(PG8_SA(0, 1), a2 + hstepA, voffA);
            PG8_WAIT_L(8); PG8_BAR; PG8_WAIT_L(0); PG8_MMA(0, 0, At, B0); PG8_BAR; PG8_SCHED;
            PG8_LDB(B1, 1, 1); PG8_STAGE(PG8_SB(1, 0), b3, voffB);
            PG8_BAR; PG8_WAIT_L(0); PG8_MMA(0, 1, At, B1); PG8_BAR;
            PG8_LDA(At, 1, 1); PG8_STAGE(PG8_SA(1, 0), a3, voffA);
            PG8_BAR; PG8_WAIT_L(0); PG8_MMA(1, 0, At, B0); PG8_BAR; PG8_SCHED;
            PG8_STAGE(PG8_SB(1, 1), b3 + hstepB, voffB);
            PG8_WAIT_V(6); PG8_BAR; PG8_MMA(1, 1, At, B1); PG8_BAR;
            }
        }
        if constexpr (ALIGN_EPI) { if (wr == 0) PG8_BAR; }
        if constexpr (!Epi::AFTER_DRAIN) { E(acc, cur, wr, wc, fr, fq); S.done(cur); }
        if (!has_next) break;
#pragma unroll
        for (int a = 0; a < 2; ++a)
#pragma unroll
            for (int b = 0; b < 2; ++b)
#pragma unroll
                for (int m = 0; m < 4; ++m)
#pragma unroll
                    for (int n = 0; n < 2; ++n) acc[a][b][m][n] = (f32x4){0.f, 0.f, 0.f, 0.f};
        cur = nxt; cA = nA; cB = nB; ++ui;
        if constexpr (ALIGN_EPI) { if (wr == 1) PG8_BAR; }
    }
    PG8_WAIT_V(0);
    if constexpr (!ALIGN_EPI) { if (wr == 0) PG8_BAR; }
    PG8_BAR;
    if constexpr (Epi::AFTER_DRAIN) { E.fused(acc, cur, wr, wc, fr, fq, lds, wid, lane); S.done(cur); }
#undef PG8_SA
#undef PG8_SB
#undef PG8_STAGE
#undef PG8_LDA
#undef PG8_LDB
#undef PG8_MMA
#undef PG8_WAIT_V
#undef PG8_WAIT_L
#undef PG8_BAR
#undef PG8_SCHED
}
}

using pg8::h16; using pg8::h16x8; using pg8::f32x4; using pg8::f32x2; using pg8::u32x4; using pg8::u32x2; using pg8::pk_h2;
#define LAS __attribute__((address_space(3)))
constexpr int NWAVES = 8;
constexpr int D = 1024, BATCH = 8, SEQ = 4096, M = BATCH * SEQ, FF = 2816, NH = 16, HD = 64;
constexpr float LN_EPS = 1e-5f;
constexpr size_t MiB = 1u << 20;
constexpr size_t WS_MOD = 0;
constexpr size_t WS_STATS = 1 * MiB;
constexpr size_t WS_DFT128 = 1 * MiB + 512 * 1024;
constexpr size_t WS_WQK = 2 * MiB, WS_WV = 6 * MiB, WS_WO = 8 * MiB, WS_FWO = 10 * MiB, WS_WUP0 = 12 * MiB, WS_WUP1 = 23 * MiB, WS_WDN0 = 34 * MiB, WS_WDN1 = 34 * MiB + 5632 * 1024, WS_EDGE = 46 * MiB;
constexpr size_t WS_U = 80 * MiB, WS_ZA = 144 * MiB, WS_BIG = 272 * MiB, WS_END = 464 * MiB;
constexpr size_t WS_QK = WS_BIG, WS_VT = WS_BIG + 128 * MiB, WS_H = WS_BIG, WS_PQT = WS_BIG, WS_F = WS_BIG + 128 * MiB;
static_assert(WS_WDN1 + 5632 * 1024 <= WS_EDGE && WS_EDGE + (size_t)512 * 6 * 2816 * 4 <= WS_U, "ws map");
constexpr int LDS_BYTES = 152 * 1024;
constexpr int ATT_K_OFF = 0, ATT_V_OFF = 73728, ATT_VSTRIDE = 1160, ATT_B_OFF = ATT_V_OFF + 64 * ATT_VSTRIDE;
static_assert(ATT_B_OFF + 2048 <= LDS_BYTES, "lds map");
constexpr int N_PHASES = 18;

struct Args { const float* in[16]; float* out; unsigned char* ws; int ph_lo, ph_hi, coop, pad; };

__device__ __forceinline__ float wave_sum(float v) {
#pragma unroll
    for (int o = 1; o < 64; o <<= 1) v += __shfl_xor(v, o);
    return v;
}
__device__ __forceinline__ int clipi(int v, int lo, int hi) { return v < lo ? lo : (v > hi ? hi : v); }

template <int KIND>
__device__ __forceinline__ void p0_transpose_item(const float* W, int ldw, int col0, int K, int ncols, h16* WT, LAS float* scr, int item, int lane) {
    const int nblk = ncols / 32, kb = item / nblk, nb = item % nblk, k0 = 64 * kb, n0 = 32 * nb;
#pragma unroll 8
    for (int i = 0; i < 32; ++i) { const int kk = 2 * i + (lane >> 5); scr[kk * 33 + (lane & 31)] = W[(size_t)(k0 + kk) * ldw + col0 + n0 + (lane & 31)]; }
    asm volatile("s_waitcnt lgkmcnt(0)" ::: "memory");
    const int c = lane & 7;
#pragma unroll
    for (int j = 0; j < 4; ++j) { const int n = (lane >> 3) + 8 * j; const LAS float* s = scr + (8 * c) * 33 + n;
        u32x4 o; o.x = pk_h2(s[0 * 33], s[1 * 33]); o.y = pk_h2(s[2 * 33], s[3 * 33]); o.z = pk_h2(s[4 * 33], s[5 * 33]); o.w = pk_h2(s[6 * 33], s[7 * 33]);
        int dr = n0 + n;
        if (KIND == 1) { const int f = dr % FF, isg = dr / FF; dr = (f >> 7) * 256 + isg * 128 + (f & 127); }
        *(u32x4*)(WT + (size_t)dr * K + k0 + 8 * c) = o; }
    asm volatile("s_waitcnt lgkmcnt(0)" ::: "memory");
}

template <int MODE, bool PERMROWS = false>
__device__ __forceinline__ void ln_rows(const float* src, const float* gam, const float* bet, const float* modsh, const float* modsc, h16* U, float* stats, float* outf, int G, int wid, int lane) {
    const int gw = blockIdx.x * NWAVES + wid, NGW = G * NWAVES;
    f32x4 gm[4], bt[4];
    if (MODE != 0) {
#pragma unroll
        for (int j = 0; j < 4; ++j) { gm[j] = *((const f32x4*)gam + lane + 64 * j); bt[j] = *((const f32x4*)bet + lane + 64 * j); }
    }
    for (int row = gw; row < M; row += NGW) {
        const int b = row >> 12;
        const f32x4* xr = (const f32x4*)(src + (size_t)row * D) + lane;
        f32x4 v[4];
#pragma unroll
        for (int j = 0; j < 4; ++j) v[j] = xr[64 * j];
        if (MODE != 0) {
            float s = 0.f;
#pragma unroll
            for (int j = 0; j < 4; ++j) s += (v[j].x + v[j].y) + (v[j].z + v[j].w);
            const float mean = wave_sum(s) * (1.f / D); float s2 = 0.f;
#pragma unroll
            for (int j = 0; j < 4; ++j) { v[j] = v[j] - mean; s2 += (v[j].x * v[j].x + v[j].y * v[j].y) + (v[j].z * v[j].z + v[j].w * v[j].w); }
            const float rstd = 1.f / sqrtf(wave_sum(s2) * (1.f / D) + LN_EPS);
            if (MODE == 1 && lane == 0) *(f32x2*)(stats + 2 * row) = (f32x2){mean, rstd};
#pragma unroll
            for (int j = 0; j < 4; ++j) v[j] = v[j] * rstd * gm[j] + bt[j];
        }
        if (MODE == 2) {
            f32x4* o = (f32x4*)(outf + (size_t)row * D) + lane;
#pragma unroll
            for (int j = 0; j < 4; ++j) o[64 * j] = v[j];
        } else {
            const f32x4* sh = (const f32x4*)(modsh + b * 6144) + lane; const f32x4* sc = (const f32x4*)(modsc + b * 6144) + lane;
            const int urow = PERMROWS ? ((row & ~4095) | ((row & 63) << 6) | ((row >> 6) & 63)) : row;
            u32x2* o8 = (u32x2*)(U + (size_t)urow * D) + lane;
#pragma unroll
            for (int j = 0; j < 4; ++j) { const f32x4 t = v[j] * (sc[64 * j] + 1.0f) + sh[64 * j]; u32x2 w; w.x = pk_h2(t.x, t.y); w.y = pk_h2(t.z, t.w); o8[64 * j] = w; }
        }
    }
}

__device__ __forceinline__ void ffn_fixup(const float* edge, const float* cw, const float* cb, h16* H, int G) {
    const int total = 512 * 2 * (FF / 4);
    for (int it = blockIdx.x * 512 + threadIdx.x; it < total; it += G * 512) {
        const int f4 = it % (FF / 4), rest = it / (FF / 4), which = rest & 1, blk = rest >> 1, f = 4 * f4;
        const float* eb = edge + (size_t)blk * 6 * FF + f;
        f32x4 p, a, q, g; const f32x4 z4 = (f32x4){0.f, 0.f, 0.f, 0.f};
        if (which == 0) { p = ((blk & 63) == 0) ? z4 : *(const f32x4*)(eb - 6 * FF + 3 * FF); a = *(const f32x4*)(eb); q = *(const f32x4*)(eb + FF); g = *(const f32x4*)(eb + 4 * FF); }
        else { p = *(const f32x4*)(eb + 2 * FF); a = *(const f32x4*)(eb + 3 * FF); q = ((blk & 63) == 63) ? z4 : *(const f32x4*)(eb + 6 * FF); g = *(const f32x4*)(eb + 5 * FF); }
        const f32x4 w0 = *(const f32x4*)(cw + f), w1 = *(const f32x4*)(cw + FF + f), w2 = *(const f32x4*)(cw + 2 * FF + f), bb = *(const f32x4*)(cb + f);
        const f32x4 v = bb + w0 * p + w1 * a + w2 * q;
        const int row = blk * 64 + (which ? 63 : 0);
        u32x2 w; w.x = pk_h2(pg8::gelu_tanh(v.x) * g.x, pg8::gelu_tanh(v.y) * g.y); w.y = pk_h2(pg8::gelu_tanh(v.z) * g.z, pg8::gelu_tanh(v.w) * g.w);
        *(u32x2*)(H + (size_t)row * FF + f) = w;
    }
}

__device__ __forceinline__ void attn_phase(LAS unsigned char* lds, const h16* QK, const h16* VT, const float* rpb, h16* AO, int G, int tid, int wid, int lane) {
    LAS unsigned char* Kl = lds + ATT_K_OFF; LAS unsigned char* Vl = lds + ATT_V_OFF; LAS float* Bl = (LAS float*)(lds + ATT_B_OFF);
    const int l15 = lane & 15, fq = lane >> 4;
    for (int uid = blockIdx.x; uid < BATCH * NH * 32; uid += G) {
        const int rp = uid & 31, h = (uid >> 5) & 15, b = uid >> 9;
        const int r0 = 2 * rp, ulo = clipi(r0 - 4, 0, 56), uhi = clipi(r0 - 3, 0, 56) + 7, nrows = uhi - ulo + 1;
        {
            const h16* kg = QK + (size_t)(b * SEQ + ulo * 64) * 2048 + 1024 + h * 64;
            const h16* vg = VT + (size_t)(h * 64) * M + b * SEQ + ulo * 64;
            u32x4 kv[9];
#pragma unroll
            for (int it = 0; it < 9; ++it) { const int c = tid + 512 * it, tok = c >> 3, ch = c & 7;
                if (tok < nrows * 64) kv[it] = *(const u32x4*)(kg + (size_t)tok * 2048 + ch * 8); }
            if (tid < 465) Bl[tid] = rpb[h * 465 + tid];
#pragma unroll
            for (int it = 0; it < 9; ++it) { const int c = tid + 512 * it, tok = c >> 3, ch = c & 7;
                if (tok < nrows * 64) *(LAS u32x4*)(Kl + tok * 128 + ((ch ^ ((tok >> 1) & 7)) * 16)) = kv[it]; }
            asm volatile("" ::: "memory");
#pragma unroll
            for (int it = 0; it < 9; ++it) { const int c = tid + 512 * it, d = c / 72, ch = c % 72;
                if (ch < nrows * 8) kv[it] = *(const u32x4*)(vg + (size_t)d * M + ch * 8); }
#pragma unroll
            for (int it = 0; it < 9; ++it) { const int c = tid + 512 * it, d = c / 72, ch = c % 72;
                if (ch < nrows * 8) { LAS u32x2* p = (LAS u32x2*)(Vl + d * ATT_VSTRIDE + ch * 16); p[0] = (u32x2){kv[it].x, kv[it].y}; p[1] = (u32x2){kv[it].z, kv[it].w}; } }
        }
        __syncthreads();
        {
            const int qr = r0 + (wid >> 2), qcb = wid & 3, rs = clipi(qr - 4, 0, 56), srow0 = rs - ulo;
            const int cq = qcb * 16 + l15, cs = clipi(cq - 8, 0, 48);
            const h16* qp = QK + (size_t)(b * SEQ + qr * 64 + cq) * 2048 + h * 64 + fq * 8;
            const h16x8 q0 = *(const h16x8*)qp, q1 = *(const h16x8*)(qp + 32);
            float mx = -INFINITY;
#pragma unroll
            for (int i = 0; i < 8; ++i) {
#pragma unroll
                for (int t = 0; t < 3; ++t) {
                    const int kcb = qcb - 1 + t;
                    if (kcb >= 0 && kcb <= 3) {
                        const int tok = (srow0 + i) * 64 + kcb * 16 + l15, sw = (tok >> 1) & 7;
                        const LAS unsigned char* kp = Kl + tok * 128;
                        const h16x8 k0 = *(const LAS h16x8*)(kp + ((fq ^ sw) * 16)), k1 = *(const LAS h16x8*)(kp + (((4 + fq) ^ sw) * 16));
                        f32x4 a = (f32x4){0.f, 0.f, 0.f, 0.f};
                        a = __builtin_amdgcn_mfma_f32_16x16x32_f16(k0, q0, a, 0, 0, 0);
                        a = __builtin_amdgcn_mfma_f32_16x16x32_f16(k1, q1, a, 0, 0, 0);
                        const LAS float* brow = Bl + (rs + i - qr + 7) * 31;
#pragma unroll
                        for (int j = 0; j < 4; ++j) { const int kc = kcb * 16 + 4 * fq + j; const bool ok = (kc >= cs) && (kc < cs + 16); const int dc = clipi(kc - cq + 15, 0, 30);
                            const float v = ok ? a[j] + brow[dc] : -INFINITY; mx = fmaxf(mx, v); }
                    }
                }
                asm volatile("" ::: "memory");
            }
            mx = fmaxf(mx, __shfl_xor(mx, 16)); mx = fmaxf(mx, __shfl_xor(mx, 32));
            const float mb = mx * 1.44269504089f; float sum = 0.f;
            f32x4 o[4];
#pragma unroll
            for (int db = 0; db < 4; ++db) o[db] = (f32x4){0.f, 0.f, 0.f, 0.f};
#pragma unroll
            for (int i2 = 0; i2 < 4; ++i2) {
#pragma unroll
                for (int t = 0; t < 3; ++t) {
                    const int kcb = qcb - 1 + t;
                    if (kcb >= 0 && kcb <= 3) {
                        h16x8 p;
#pragma unroll
                        for (int e = 0; e < 2; ++e) {
                            const int i = 2 * i2 + e;
                            const int tok = (srow0 + i) * 64 + kcb * 16 + l15, sw = (tok >> 1) & 7;
                            const LAS unsigned char* kp = Kl + tok * 128;
                            const h16x8 k0 = *(const LAS h16x8*)(kp + ((fq ^ sw) * 16)), k1 = *(const LAS h16x8*)(kp + (((4 + fq) ^ sw) * 16));
                            f32x4 a = (f32x4){0.f, 0.f, 0.f, 0.f};
                            a = __builtin_amdgcn_mfma_f32_16x16x32_f16(k0, q0, a, 0, 0, 0);
                            a = __builtin_amdgcn_mfma_f32_16x16x32_f16(k1, q1, a, 0, 0, 0);
                            const LAS float* brow = Bl + (rs + i - qr + 7) * 31;
#pragma unroll
                            for (int j = 0; j < 4; ++j) { const int kc = kcb * 16 + 4 * fq + j; const bool ok = (kc >= cs) && (kc < cs + 16); const int dc = clipi(kc - cq + 15, 0, 30);
                                const float v = ok ? a[j] + brow[dc] : -INFINITY; const float pe = __builtin_amdgcn_exp2f(v * 1.44269504089f - mb); sum += pe; p[4 * e + j] = (h16)pe; }
                        }
                        const int tok0 = (srow0 + 2 * i2) * 64 + kcb * 16 + 4 * fq;
#pragma unroll
                        for (int db = 0; db < 4; ++db) {
                            const LAS unsigned char* vp = Vl + (db * 16 + l15) * ATT_VSTRIDE + tok0 * 2;
                            const u32x2 lo = *(const LAS u32x2*)vp, hi = *(const LAS u32x2*)(vp + 128);
                            const u32x4 vw = (u32x4){lo.x, lo.y, hi.x, hi.y};
                            o[db] = __builtin_amdgcn_mfma_f32_16x16x32_f16(__builtin_bit_cast(h16x8, vw), p, o[db], 0, 0, 0);
                        }
                    }
                    asm volatile("" ::: "memory");
                }
            }
            sum += __shfl_xor(sum, 16); sum += __shfl_xor(sum, 32);
            const float inv = 1.0f / sum;
            h16* op = AO + (size_t)(b * SEQ + qr * 64 + cq) * D + h * 64 + 4 * fq;
#pragma unroll
            for (int db = 0; db < 4; ++db) { const f32x4 v = o[db] * inv; u32x2 w; w.x = pk_h2(v.x, v.y); w.y = pk_h2(v.z, v.w); *(u32x2*)(op + db * 16) = w; }
        }
        __syncthreads();
    }
}

constexpr int DF_TW_OFF = 0, DF_OM_OFF = 32768, DF_PHI_OFF = 65536, DF_OUT_OFF = 81920, DF_OUT_ROW = 136;
static_assert(DF_OUT_OFF + 8 * 64 * DF_OUT_ROW <= LDS_BYTES, "dft lds map");
__device__ __forceinline__ void dft2d_phase(LAS unsigned char* lds, const h16* PQT, h16* Y, int G, int tid, int wid, int lane) {
    LAS f32x2* TW = (LAS f32x2*)(lds + DF_TW_OFF);
    LAS unsigned char* OmL = lds + DF_OM_OFF;
    LAS unsigned char* Ol = lds + DF_OUT_OFF;
    const int n = lane & 15, kq = lane >> 4;
    for (int i = tid; i < 4096; i += 512) { float sn, cs; sincospif((float)i * (1.0f / 2048.0f), &sn, &cs); TW[i] = (f32x2){cs, sn}; }
    __syncthreads();
    for (int f = wid; f < 32; f += NWAVES) {
        const int nt = f >> 2, ks = f & 3, p = 16 * (nt >> 1) + n, rip = nt & 1, ri = ks >> 1;
        h16x8 v;
#pragma unroll
        for (int e = 0; e < 8; ++e) { const int a = 32 * (ks & 1) + 8 * kq + e; const f32x2 t = TW[((p * a) & 63) * 64];
            const float val = (rip == ri) ? t.x : (rip == 0 ? t.y : -t.y);
            v[e] = (h16)(val * 0.125f); }
        *(LAS h16x8*)(OmL + (f * 64 + lane) * 16) = v;
    }
    LAS unsigned char* PhL = lds + DF_PHI_OFF;
    for (int f = wid; f < 16; f += NWAVES) {
        const int qt = f >> 2, ks2 = f & 3, q = 16 * qt + n;
        h16x8 v;
#pragma unroll
        for (int e = 0; e < 8; ++e) { const int c = 32 * (ks2 & 1) + 16 * (e >> 2) + 4 * kq + (e & 3); const f32x2 t = TW[((q * c) & 63) * 64];
            v[e] = (h16)(((ks2 >> 1) ? t.y : t.x) * 0.125f); }
        *(LAS h16x8*)(PhL + (f * 64 + lane) * 16) = v;
    }
    __syncthreads();
    for (int it = blockIdx.x; it < 1024; it += G) {
        int cb = it;
        if (G == 256) { const int bx = it & 255, i = it >> 8, x = bx & 7, y = bx >> 3; cb = (x * 16 + (y >> 3) * 4 + i) * 8 + (y & 7); }
        const int b = cb >> 7, ch = (cb & 127) * 8 + wid;
        const h16* zp = PQT + (size_t)(b * 1024 + ch) * 8192 + n * 64 + 8 * kq;
        h16x8 zt[4][4];
#pragma unroll
        for (int ct = 0; ct < 4; ++ct)
#pragma unroll
            for (int ks = 0; ks < 4; ++ks) zt[ct][ks] = *(const h16x8*)(zp + (ks >> 1) * 4096 + ct * 1024 + (ks & 1) * 32);
#pragma unroll
        for (int pt = 0; pt < 4; ++pt) {
            f32x4 aR[4], aI[4];
#pragma unroll
            for (int ct = 0; ct < 4; ++ct) { aR[ct] = (f32x4){0.f, 0.f, 0.f, 0.f}; aI[ct] = (f32x4){0.f, 0.f, 0.f, 0.f}; }
#pragma unroll
            for (int ks = 0; ks < 4; ++ks) {
                const h16x8 bR = *(const LAS h16x8*)(OmL + (((2 * pt) * 4 + ks) * 64 + lane) * 16), bI = *(const LAS h16x8*)(OmL + (((2 * pt + 1) * 4 + ks) * 64 + lane) * 16);
#pragma unroll
                for (int ct = 0; ct < 4; ++ct) { aR[ct] = __builtin_amdgcn_mfma_f32_16x16x32_f16(zt[ct][ks], bR, aR[ct], 0, 0, 0); aI[ct] = __builtin_amdgcn_mfma_f32_16x16x32_f16(zt[ct][ks], bI, aI[ct], 0, 0, 0); }
            }
            const int p = 16 * pt + n;
            h16x8 tpR[2], tpI[2];
#pragma unroll
            for (int ct = 0; ct < 4; ++ct)
#pragma unroll
                for (int j = 0; j < 4; ++j) { const int c = 16 * ct + 4 * kq + j; const f32x2 t = TW[(c * p) & 4095];
                    const float tr = aR[ct][j], ti = aI[ct][j];
                    tpR[ct >> 1][4 * (ct & 1) + j] = (h16)(tr * t.x + ti * t.y); tpI[ct >> 1][4 * (ct & 1) + j] = (h16)(ti * t.x - tr * t.y); }
#pragma unroll
            for (int qt = 0; qt < 4; ++qt) {
                f32x4 d = (f32x4){0.f, 0.f, 0.f, 0.f};
                const LAS h16x8* ph = (const LAS h16x8*)(PhL + ((qt * 4) * 64 + lane) * 16);
                d = __builtin_amdgcn_mfma_f32_16x16x32_f16(tpR[0], ph[0], d, 0, 0, 0);
                d = __builtin_amdgcn_mfma_f32_16x16x32_f16(tpR[1], ph[64], d, 0, 0, 0);
                d = __builtin_amdgcn_mfma_f32_16x16x32_f16(tpI[0], ph[128], d, 0, 0, 0);
                d = __builtin_amdgcn_mfma_f32_16x16x32_f16(tpI[1], ph[192], d, 0, 0, 0);
                u32x2 w; w.x = pk_h2(d[0], d[1]); w.y = pk_h2(d[2], d[3]);
                *(LAS u32x2*)(Ol + (wid * 64 + 16 * qt + n) * DF_OUT_ROW + (16 * pt + 4 * kq) * 2) = w;
            }
            asm volatile("" ::: "memory");
        }
        __syncthreads();
        {
            h16* yb = Y + (size_t)(b * SEQ) * D + (cb & 127) * 8;
#pragma unroll
            for (int r = 0; r < 8; ++r) {
                const int k = tid + 512 * r, q = k >> 6, p = k & 63;
                unsigned short hv[8];
#pragma unroll
                for (int w = 0; w < 8; ++w) hv[w] = *(const LAS unsigned short*)(Ol + (w * 64 + q) * DF_OUT_ROW + p * 2);
                u32x4 o; o.x = hv[0] | ((unsigned)hv[1] << 16); o.y = hv[2] | ((unsigned)hv[3] << 16); o.z = hv[4] | ((unsigned)hv[5] << 16); o.w = hv[6] | ((unsigned)hv[7] << 16);
                *(u32x4*)(yb + (size_t)k * D) = o;
            }
        }
        __syncthreads();
    }
}

__global__ void __launch_bounds__(NWAVES * 64, 2) mega_fwd(Args args) {
    extern __shared__ __attribute__((aligned(16))) unsigned char lds_raw[];
    LAS unsigned char* lds = (LAS unsigned char*)lds_raw;
    cg::grid_group grid = cg::this_grid();
    const int tid = threadIdx.x, lane = tid & 63, wid = __builtin_amdgcn_readfirstlane(tid >> 6);
    const int G = gridDim.x;
    unsigned char* ws = args.ws;
    const float* x = args.in[0]; const float* cvec = args.in[1]; const float* ada_w = args.in[2]; const float* ada_b = args.in[3];
    const float* w_qkv = args.in[4]; const float* rpb = args.in[5]; const float* na_wo = args.in[6]; const float* fn_wo = args.in[7];
    const float* ln1_g = args.in[8]; const float* ln1_b = args.in[9]; const float* w_up = args.in[10]; const float* conv_w = args.in[11];
    const float* conv_b = args.in[12]; const float* w_down = args.in[13]; const float* ln2_g = args.in[14]; const float* ln2_b = args.in[15];
    float* out = args.out;
    float* mod = (float*)(ws + WS_MOD); float* stats = (float*)(ws + WS_STATS);
    h16* DFT128 = (h16*)(ws + WS_DFT128);
    h16* Wqk_t = (h16*)(ws + WS_WQK); h16* Wv_t = (h16*)(ws + WS_WV); h16* Wo_t = (h16*)(ws + WS_WO); h16* Fwo_t = (h16*)(ws + WS_FWO);
    h16* Wup0 = (h16*)(ws + WS_WUP0); h16* Wup1 = (h16*)(ws + WS_WUP1); h16* Wdn0 = (h16*)(ws + WS_WDN0); h16* Wdn1 = (h16*)(ws + WS_WDN1);
    float* edge = (float*)(ws + WS_EDGE);
    h16* U = (h16*)(ws + WS_U); float* ZA = (float*)(ws + WS_ZA);
    h16* QKb = (h16*)(ws + WS_QK); h16* VTb = (h16*)(ws + WS_VT); h16* Hb = (h16*)(ws + WS_H); h16* PQT = (h16*)(ws + WS_PQT);

    const int lo = args.ph_lo, hi = args.ph_hi;
#define IN(k) (lo <= (k) && (k) < hi)
#define SEAM(k) do { if (IN(k) && IN((k) + 1)) grid.sync(); } while (0)
    const size_t T1K = (size_t)256 * 1024 * 2;

    if (IN(0)) {
        LAS float* scr = (LAS float*)(lds + wid * 8448);
        const int gw = blockIdx.x * NWAVES + wid, NGW = G * NWAVES;
        constexpr int I_QK = 16 * 64, I_V = 16 * 32, I_O = 16 * 32, I_UP = 16 * 176, I_DN = 44 * 32;
        constexpr int NITEMS = I_QK + I_V + 2 * I_O + 2 * I_UP + 2 * I_DN;
        for (int it = gw; it < NITEMS; it += NGW) {
            int r = it;
            if (r < I_QK) { p0_transpose_item<0>(w_qkv, 3072, 0, 1024, 2048, Wqk_t, scr, r, lane); continue; } r -= I_QK;
            if (r < I_V) { p0_transpose_item<0>(w_qkv, 3072, 2048, 1024, 1024, Wv_t, scr, r, lane); continue; } r -= I_V;
            if (r < I_O) { p0_transpose_item<0>(na_wo, 1024, 0, 1024, 1024, Wo_t, scr, r, lane); continue; } r -= I_O;
            if (r < I_O) { p0_transpose_item<0>(fn_wo, 1024, 0, 1024, 1024, Fwo_t, scr, r, lane); continue; } r -= I_O;
            if (r < I_UP) { p0_transpose_item<1>(w_up, 5632, 0, 1024, 5632, Wup0, scr, r, lane); continue; } r -= I_UP;
            if (r < I_UP) { p0_transpose_item<1>(w_up + (size_t)1024 * 5632, 5632, 0, 1024, 5632, Wup1, scr, r, lane); continue; } r -= I_UP;
            if (r < I_DN) { p0_transpose_item<0>(w_down, 1024, 0, 2816, 1024, Wdn0, scr, r, lane); continue; } r -= I_DN;
            p0_transpose_item<0>(w_down + (size_t)2816 * 1024, 1024, 0, 2816, 1024, Wdn1, scr, r, lane);
        }
        for (int e = blockIdx.x * 512 + tid; e < 256 * 128; e += G * 512) {
            const int row = e >> 7, c = e & 127, ri = row >> 7, m = row & 127; const float ph = (float)((m * c) & 127) * (1.0f / 128.0f);
            const float v = (ri ? -__builtin_amdgcn_sinf(ph) : __builtin_amdgcn_cosf(ph)) * 0.08838834764831845f;
            DFT128[e] = (h16)v;
        }
        __syncthreads();
        LAS float* cs = (LAS float*)(lds + 80 * 1024);
        LAS float* red = (LAS float*)(lds + 112 * 1024);
        if (blockIdx.x < 192) {
            for (int i = tid; i < 8 * 1024; i += 512) { const float v = cvec[i]; cs[i] = v / (1.0f + __expf(-v)); }
            __syncthreads();
            for (int it = blockIdx.x; it < 192; it += G) {
                const int li = it / 96, e0 = (it % 96) * 64;
                const float* wp = ada_w + (size_t)li * 1024 * 6144 + (size_t)(wid * 128) * 6144 + e0 + lane;
                float a[8];
#pragma unroll
                for (int b = 0; b < 8; ++b) a[b] = 0.f;
#pragma unroll 8
                for (int d = 0; d < 128; ++d) { const float w = wp[(size_t)d * 6144];
#pragma unroll
                    for (int b = 0; b < 8; ++b) a[b] += w * cs[b * 1024 + wid * 128 + d]; }
#pragma unroll
                for (int b = 0; b < 8; ++b) red[(wid * 8 + b) * 64 + lane] = a[b];
                __syncthreads();
                { const int b = tid >> 6, col = tid & 63; float s = ada_b[li * 6144 + e0 + col];
#pragma unroll
                  for (int w = 0; w < 8; ++w) s += red[(w * 8 + b) * 64 + col];
                  mod[(size_t)(li * 8 + b) * 6144 + e0 + col] = s; }
                __syncthreads();
            }
        }
    }
    SEAM(0);
    const float* mod0 = mod; const float* mod1 = mod + 8 * 6144;

    if (IN(1)) ln_rows<0>(x, nullptr, nullptr, mod0 + 0 * 1024, mod0 + 1 * 1024, U, nullptr, nullptr, G, wid, lane);
    SEAM(1);
    if (IN(2)) {
        { pg8::Gemm g{U, Wqk_t, 1024, 1024, 1024, T1K, T1K, 0}; pg8::StaticOrder S; S.init(M, 2048, G, (int)blockIdx.x);
          pg8::EpiH16 E{QKb, 2048, 0, 0, 1024, 0.125f};
          pg8::gemm_phase<pg8::EpiH16, pg8::StaticOrder, true, true>(lds, g, S, E); }
        { pg8::Gemm g{Wv_t, U, 1024, 1024, 1024, T1K, T1K, 0}; pg8::StaticOrder S; S.init(1024, M, G, (int)blockIdx.x);
          pg8::EpiH16 E{VTb, M, 0, 0, 0, 1.f};
          pg8::gemm_phase<pg8::EpiH16, pg8::StaticOrder, true, true>(lds, g, S, E); }
    }
    SEAM(2);
    if (IN(3)) attn_phase(lds, QKb, VTb, rpb, U, G, tid, wid, lane);
    SEAM(3);
    if (IN(4)) { pg8::Gemm g{U, Wo_t, 1024, 1024, 1024, T1K, T1K, 0}; pg8::StaticOrder S; S.init(M, 1024, G, (int)blockIdx.x);
        pg8::EpiRes E{x, nullptr, nullptr, nullptr, mod0 + 2 * 1024, ZA};
        pg8::gemm_phase<pg8::EpiRes, pg8::StaticOrder, true, true>(lds, g, S, E); }
    SEAM(4);
#pragma unroll
    for (int L = 0; L < 2; ++L) {
        const int pb = (L == 0) ? 5 : 13;
        const float* modL = L ? mod1 : mod0;
        if (IN(pb)) ln_rows<1>(ZA, ln1_g + L * 1024, ln1_b + L * 1024, modL + 3 * 1024, modL + 4 * 1024, U, stats, nullptr, G, wid, lane);
        SEAM(pb);
        if (IN(pb + 1)) { pg8::Gemm g{U, L ? Wup1 : Wup0, 1024, 1024, 1024, T1K, T1K, 0}; pg8::StaticOrder S; S.init(M, 2 * FF, G, (int)blockIdx.x);
            pg8::EpiUp E{conv_w + (size_t)L * 3 * FF, conv_b + L * FF, Hb, edge};
            pg8::gemm_phase<pg8::EpiUp, pg8::StaticOrder, true, true>(lds, g, S, E); }
        SEAM(pb + 1);
        if (IN(pb + 2)) ffn_fixup(edge, conv_w + (size_t)L * 3 * FF, conv_b + L * FF, Hb, G);
        SEAM(pb + 2);
        if (IN(pb + 3)) { pg8::Gemm g{Hb, L ? Wdn1 : Wdn0, FF, FF, FF, (size_t)256 * FF * 2, (size_t)256 * FF * 2, 0}; pg8::StaticOrder S; S.init(M, 1024, G, (int)blockIdx.x);
            pg8::EpiRes E{ZA, stats, ln1_g + L * 1024, ln1_b + L * 1024, modL + 5 * 1024, out};
            pg8::gemm_phase<pg8::EpiRes, pg8::StaticOrder, true, true>(lds, g, S, E); }
        SEAM(pb + 3);
        if (L == 0) {
            if (IN(9)) {
                ln_rows<1, true>(out, ln2_g, ln2_b, mod1 + 0 * 1024, mod1 + 1 * 1024, U, stats, nullptr, G, wid, lane);
            }
            SEAM(9);
            if (IN(10)) { int k128 = 128; asm volatile("" : "+s"(k128)); pg8::Gemm g{DFT128, U, 128, 1024, k128, 0, T1K, 256}; pg8::StaticOrder S; S.init(8 * 256, M, G, (int)blockIdx.x);
                pg8::EpiF1 E{PQT};
                pg8::gemm_phase<pg8::EpiF1, pg8::StaticOrder, true, true>(lds, g, S, E); }
            SEAM(10);
            if (IN(11)) dft2d_phase(lds, PQT, U, G, tid, wid, lane);
            SEAM(11);
            if (IN(12)) { pg8::Gemm g{U, Fwo_t, 1024, 1024, 1024, T1K, T1K, 0}; pg8::StaticOrder S; S.init(M, 1024, G, (int)blockIdx.x);
                pg8::EpiRes E{out, stats, ln2_g, ln2_b, mod1 + 2 * 1024, ZA};
                pg8::gemm_phase<pg8::EpiRes, pg8::StaticOrder, true, true>(lds, g, S, E); }
            SEAM(12);
        }
    }
    if (IN(17)) ln_rows<2>(out, ln2_g + 1024, ln2_b + 1024, nullptr, nullptr, nullptr, nullptr, out, G, wid, lane);
#undef IN
#undef SEAM
}

extern "C" void kernel_launch(void* const* d_in, const int* in_sizes, int n_in, void* d_out, int out_size, void* d_ws, size_t ws_size, hipStream_t stream) {
    static int grid = 0;
    if (grid == 0) {
        if (n_in != 16 || out_size != M * D || ws_size < WS_END) { fprintf(stderr, "kernel_launch: unexpected shapes (n_in %d out %d ws %zu)\n", n_in, out_size, ws_size); grid = -1; return; }
        int dev = 0, cus = 0, per_cu = 0;
        hipGetDevice(&dev); hipDeviceGetAttribute(&cus, hipDeviceAttributeMultiprocessorCount, dev);
        if (hipFuncSetAttribute((const void*)mega_fwd, hipFuncAttributeMaxDynamicSharedMemorySize, LDS_BYTES) != hipSuccess) { fprintf(stderr, "kernel_launch: hipFuncSetAttribute failed\n"); grid = -1; return; }
        if (hipOccupancyMaxActiveBlocksPerMultiprocessor(&per_cu, (const void*)mega_fwd, NWAVES * 64, LDS_BYTES) != hipSuccess || per_cu < 1) { fprintf(stderr, "kernel_launch: occupancy query says %d\n", per_cu); per_cu = 1; }
        (void)hipGetLastError();
        grid = cus;
        fprintf(stderr, "kernel_launch: grid %d (cus %d, per_cu %d)\n", grid, cus, per_cu);
    }
    if (grid < 0) return;
    Args a{};
    for (int i = 0; i < 16; ++i) a.in[i] = (const float*)d_in[i];
    a.out = (float*)d_out; a.ws = (unsigned char*)d_ws;
#if MK_ONE_LAUNCH
    a.ph_lo = 0; a.ph_hi = N_PHASES; a.coop = 1;
    void* kargs[] = {&a};
    hipError_t e = hipLaunchCooperativeKernel((const void*)mega_fwd, dim3(grid), dim3(NWAVES * 64), kargs, LDS_BYTES, stream);
    if (e != hipSuccess) fprintf(stderr, "cooperative launch failed: %s (grid %d)\n", hipGetErrorString(e), grid);
#else
    for (int p = 0; p < N_PHASES; ++p) { a.ph_lo = p; a.ph_hi = p + 1; a.coop = 0;
        hipLaunchKernelGGL(mega_fwd, dim3(grid), dim3(NWAVES * 64), LDS_BYTES, stream, a); }
#endif
}
```

```cpp
#include <hip/hip_runtime.h>
#include <hip/hip_cooperative_groups.h>
#include <cstdio>
#include <cstdint>
namespace cg = cooperative_groups;

#ifndef MK_ONE_LAUNCH
#define MK_ONE_LAUNCH 1
#endif

namespace pg8 {
#define PG8_LAS __attribute__((address_space(3)))
typedef _Float16 h16;
typedef _Float16 h16x8 __attribute__((ext_vector_type(8)));
typedef _Float16 h16x2 __attribute__((ext_vector_type(2)));
typedef float f32x4 __attribute__((ext_vector_type(4)));
typedef float f32x2 __attribute__((ext_vector_type(2)));
typedef unsigned u32x4 __attribute__((ext_vector_type(4)));
typedef unsigned u32x2 __attribute__((ext_vector_type(2)));
constexpr int BM = 256, BK = 64, HALF = 128, HTB = HALF * BK * 2  , STAGE_BYTES = 8 * HTB, NXCD = 8, WGM = 8;

__host__ __device__ __forceinline__ int lds_byte(int r, int c) { const int st = (r >> 4) * 2 + (c >> 5), rr = r & 15, cc = c & 31, ob = rr * 64 + cc * 2; return st * 1024 + (ob ^ (((ob >> 9) & 1) << 5)); }
__host__ __device__ __forceinline__ void stage_rc(int b, int& R, int& C) { const int st = b / 1024, sb = b % 1024, swz = sb ^ (((sb >> 9) & 1) << 5); R = (st >> 1) * 16 + swz / 64; C = (st & 1) * 32 + (swz % 64) / 2; }
__host__ __device__ __forceinline__ int perm32(int rho) { const int n = rho >> 4, i = rho & 15; return 8 * (i >> 2) + 4 * n + (i & 3); }

struct Unit { int pm, pn; };
struct Gemm { const h16* A; const h16* Bt; int lda, ldb, K; size_t a_tile, b_tile, b_pm_koff; };

struct StaticOrder {
    int nM, nN, nwg, G, c;
    __host__ __device__ void init(int M, int N, int G_, int c_) { nM = M / BM; nN = N / BM; nwg = nM * nN; G = G_; c = c_; }
    __host__ __device__ bool next(int i, Unit& u) const {
        const long L = (long)i * G + c; if (L >= nwg) return false;
        int wgid = (int)L; { const int q = nwg / NXCD, r = nwg % NXCD, xcd = wgid % NXCD, off = wgid / NXCD; wgid = (xcd < r ? xcd * (q + 1) : r * (q + 1) + (xcd - r) * q) + off; }
        const int nig = WGM * nN, gid = wgid / nig, fm = gid * WGM, gsz = (nM - fm) < WGM ? (nM - fm) : WGM;
        u.pm = fm + ((wgid % nig) % gsz); u.pn = (wgid % nig) / gsz; return true;
    }
    __device__ __forceinline__ void a_ready(const Unit&) const {}
    __device__ __forceinline__ void done(const Unit&) const {}
};

__device__ __forceinline__ unsigned pk_h2(float lo, float hi) { h16x2 v; v.x = (h16)lo; v.y = (h16)hi; return __builtin_bit_cast(unsigned, v); }


struct EpiH16 {
    static constexpr bool PERM = true, AFTER_DRAIN = false;
    h16* O; int ldc; int split_cols; size_t split_stride; int scale_cols; float scale;
    __device__ __forceinline__ void operator()(const f32x4 (&acc)[2][2][4][2], const Unit& u, int wr, int wc, int fr, int fq) const {
        const int row0 = u.pm * BM + wr * 64 + fr; int colt = u.pn * BM; h16* base = O;
        const float sc = (colt < scale_cols) ? scale : 1.f;
        if (split_cols) { const int t = colt / split_cols; base += (size_t)t * split_stride; colt -= t * split_cols; }
        const int col0 = colt + wc * 32 + 8 * fq;
#pragma unroll
        for (int ai = 0; ai < 2; ++ai)
#pragma unroll
            for (int m = 0; m < 4; ++m) { h16* rowp = base + (size_t)(row0 + ai * HALF + m * 16) * ldc + col0;
#pragma unroll
                for (int bj = 0; bj < 2; ++bj) { const f32x4 v0 = acc[ai][bj][m][0] * sc, v1 = acc[ai][bj][m][1] * sc;
                    u32x4 w; w.x = pk_h2(v0[0], v0[1]); w.y = pk_h2(v0[2], v0[3]); w.z = pk_h2(v1[0], v1[1]); w.w = pk_h2(v1[2], v1[3]);
                    *(u32x4*)(rowp + bj * HALF) = w; } }
    }
};

struct EpiF1 {
    static constexpr bool PERM = true, AFTER_DRAIN = false;
    h16* PQT;
    __device__ __forceinline__ void operator()(const f32x4 (&acc)[2][2][4][2], const Unit& u, int wr, int wc, int fr, int fq) const {
        const int b = u.pn >> 4, s0 = (u.pn & 15) * 256 + wc * 32 + 8 * fq;
#pragma unroll
        for (int ai = 0; ai < 2; ++ai)
#pragma unroll
            for (int m = 0; m < 4; ++m) { h16* rowp = PQT + (size_t)(b * 1024 + u.pm * 128 + wr * 64 + m * 16 + fr) * 8192 + ai * 4096 + s0;
#pragma unroll
                for (int bj = 0; bj < 2; ++bj) { const f32x4 v0 = acc[ai][bj][m][0], v1 = acc[ai][bj][m][1];
                    u32x4 w; w.x = pk_h2(v0[0], v0[1]); w.y = pk_h2(v0[2], v0[3]); w.z = pk_h2(v1[0], v1[1]); w.w = pk_h2(v1[2], v1[3]);
                    *(u32x4*)(rowp + bj * HALF) = w; } }
    }
};

struct EpiRes {
    static constexpr bool PERM = false, AFTER_DRAIN = false;
    const float* res; const float* stats; const float* gam; const float* bet; const float* gate; float* out;
    __device__ __forceinline__ void operator()(const f32x4 (&acc)[2][2][4][2], const Unit& u, int wr, int wc, int fr, int fq) const {
        const int b = u.pm >> 4; const float ALPHA = 1.41421356237f;
#pragma unroll
        for (int bj = 0; bj < 2; ++bj)
#pragma unroll
            for (int n = 0; n < 2; ++n) {
                const int col = u.pn * BM + bj * HALF + wc * 32 + n * 16 + 4 * fq;
                const f32x4 gt = *(const f32x4*)(gate + b * 6144 + col) + 1.0f;
                f32x4 gm = (f32x4){1.f, 1.f, 1.f, 1.f}, bt = (f32x4){0.f, 0.f, 0.f, 0.f};
                if (stats) { gm = *(const f32x4*)(gam + col); bt = *(const f32x4*)(bet + col); }
#pragma unroll
                for (int ai = 0; ai < 2; ++ai)
#pragma unroll
                    for (int m = 0; m < 4; ++m) {
                        const int row = u.pm * BM + ai * HALF + wr * 64 + m * 16 + fr;
                        f32x4 r = *(const f32x4*)(res + (size_t)row * 1024 + col);
                        if (stats) { const f32x2 st = *(const f32x2*)(stats + 2 * row); r = (r - st.x) * st.y * gm + bt; }
                        const f32x4 o = r * ALPHA + gt * acc[ai][bj][m][n];
                        *(f32x4*)(out + (size_t)row * 1024 + col) = o;
                    }
            }
    }
};

__device__ __forceinline__ float dpp_prev(float old, float src) {
    return __builtin_bit_cast(float, __builtin_amdgcn_update_dpp(__builtin_bit_cast(int, old), __builtin_bit_cast(int, src), 0x111, 0xf, 0xf, false)); }
__device__ __forceinline__ float dpp_next(float old, float src) {
    return __builtin_bit_cast(float, __builtin_amdgcn_update_dpp(__builtin_bit_cast(int, old), __builtin_bit_cast(int, src), 0x101, 0xf, 0xf, false)); }
__device__ __forceinline__ float dpp_ror1(float src) {
    return __builtin_bit_cast(float, __builtin_amdgcn_update_dpp(0, __builtin_bit_cast(int, src), 0x121, 0xf, 0xf, false)); }
__device__ __forceinline__ float dpp_ror15(float src) {
    return __builtin_bit_cast(float, __builtin_amdgcn_update_dpp(0, __builtin_bit_cast(int, src), 0x12f, 0xf, 0xf, false)); }
__device__ __forceinline__ float gelu_tanh(float v) {
    const float y = v + 0.044715f * v * v * v;
    const float e = __builtin_amdgcn_exp2f(-2.302208198f * y);
    return v * __builtin_amdgcn_rcpf(1.0f + e);
}

struct EpiUp {
    static constexpr bool PERM = true, AFTER_DRAIN = false;
    const float* cw; const float* cb; h16* H; float* edge;
    __device__ __forceinline__ void operator()(const f32x4 (&acc)[2][2][4][2], const Unit& u, int wr, int wc, int fr, int fq) const {
        const int f0 = u.pn * 128 + wc * 32 + 8 * fq;
        f32x4 w0[2], w1[2], w2[2], bb[2];
#pragma unroll
        for (int n = 0; n < 2; ++n) { w0[n] = *(const f32x4*)(cw + f0 + 4 * n); w1[n] = *(const f32x4*)(cw + 2816 + f0 + 4 * n); w2[n] = *(const f32x4*)(cw + 2 * 2816 + f0 + 4 * n); bb[n] = *(const f32x4*)(cb + f0 + 4 * n); }
#pragma unroll
        for (int ai = 0; ai < 2; ++ai) {
            const int blk = u.pm * 4 + ai * 2 + wr;
            float* eb = edge + (size_t)blk * 6 * 2816 + f0;
#pragma unroll
            for (int m = 0; m < 4; ++m) {
                unsigned pk[4];
#pragma unroll
                for (int n = 0; n < 2; ++n) {
                    const f32x4 a = acc[ai][0][m][n], g = acc[ai][1][m][n];
                    f32x4 hv;
#pragma unroll
                    for (int j = 0; j < 4; ++j) {
                        const float po = (m > 0) ? dpp_ror1(acc[ai][0][m > 0 ? m - 1 : 0][n][j]) : 0.f;
                        const float no = (m < 3) ? dpp_ror15(acc[ai][0][m < 3 ? m + 1 : 3][n][j]) : 0.f;
                        const float p = dpp_prev(po, a[j]), q = dpp_next(no, a[j]);
                        const float v = bb[n][j] + w0[n][j] * p + w1[n][j] * a[j] + w2[n][j] * q;
                        hv[j] = gelu_tanh(v) * g[j];
                    }
                    pk[2 * n] = pk_h2(hv[0], hv[1]); pk[2 * n + 1] = pk_h2(hv[2], hv[3]);
                    if (m == 0) { if (fr == 0) { *(f32x4*)(eb + 0 * 2816 + 4 * n) = a; *(f32x4*)(eb + 4 * 2816 + 4 * n) = g; } if (fr == 1) *(f32x4*)(eb + 1 * 2816 + 4 * n) = a; }
                    if (m == 3) { if (fr == 14) *(f32x4*)(eb + 2 * 2816 + 4 * n) = a; if (fr == 15) { *(f32x4*)(eb + 3 * 2816 + 4 * n) = a; *(f32x4*)(eb + 5 * 2816 + 4 * n) = g; } }
                }
                const int row = u.pm * BM + ai * HALF + wr * 64 + m * 16 + fr;
                u32x4 w; w.x = pk[0]; w.y = pk[1]; w.z = pk[2]; w.w = pk[3];
                *(u32x4*)(H + (size_t)row * 2816 + f0) = w;
            }
        }
    }
};

template <class Epi, class Sched, bool ALIGN_EPI = false, bool SP2 = false>
__device__ __forceinline__ void gemm_phase(PG8_LAS unsigned char* lds, const Gemm g, const Sched& S, const Epi& E) {
    int tid_ = threadIdx.x; asm volatile("" : "+v"(tid_));
    const int tid = tid_, wid = __builtin_amdgcn_readfirstlane(tid >> 6), lane = tid & 63, wr = wid >> 2, wc = wid & 3, fr = lane & 15, fq = lane >> 4;
    const int K = g.K, nt = K / BK;
    unsigned voffA[2], voffB[2];
#pragma unroll
    for (int i = 0; i < 2; ++i) { int R, C; stage_rc(tid * 16 + i * 8192, R, C); const int Rb = Epi::PERM ? ((R & ~31) + perm32(R & 31)) : R;
        voffA[i] = (unsigned)(R * g.lda + C) * 2u; voffB[i] = (unsigned)(Rb * g.ldb + C) * 2u; }
    const size_t kstep = (size_t)(BK * 2);
    const size_t hstepA = (size_t)HALF * g.lda * 2, hstepB = (size_t)HALF * g.ldb * 2;
    const unsigned ldsw = (unsigned)wid * 1024u;
    const int aoff = lds_byte(wr * 64 + fr, fq * 8), boff = lds_byte(wc * 32 + fr, fq * 8);
#define PG8_SA(b, h) (((b) * 2 + (h)) * HTB)
#define PG8_SB(b, h) ((4 + (b) * 2 + (h)) * HTB)
#define PG8_STAGE(bufoff, gbase, voff) do { _Pragma("unroll") for (int _i = 0; _i < 2; ++_i) \
        __builtin_amdgcn_global_load_lds((const unsigned*)((const char*)(gbase) + (voff)[_i]), (PG8_LAS unsigned*)(lds + (bufoff) + ldsw + _i * 8192), 16, 0, 0); } while (0)
#define PG8_LDA(dst, b, h) do { _Pragma("unroll") for (int m = 0; m < 4; ++m) _Pragma("unroll") for (int k = 0; k < 2; ++k) dst[m][k] = *(const PG8_LAS h16x8*)(lds + PG8_SA(b, h) + aoff + m * 2048 + k * 1024); } while (0)
#define PG8_LDB(dst, b, h) do { _Pragma("unroll") for (int n = 0; n < 2; ++n) _Pragma("unroll") for (int k = 0; k < 2; ++k) dst[n][k] = *(const PG8_LAS h16x8*)(lds + PG8_SB(b, h) + boff + n * 2048 + k * 1024); } while (0)
#define PG8_MMA(ai, bj, At, Bt) do { __builtin_amdgcn_s_setprio(1); _Pragma("unroll") for (int m = 0; m < 4; ++m) _Pragma("unroll") for (int n = 0; n < 2; ++n) _Pragma("unroll") for (int k = 0; k < 2; ++k) \
        acc[ai][bj][m][n] = __builtin_amdgcn_mfma_f32_16x16x32_f16(Bt[n][k], At[m][k], acc[ai][bj][m][n], 0, 0, 0); __builtin_amdgcn_s_setprio(0); } while (0)
#define PG8_WAIT_V(n) asm volatile("s_waitcnt vmcnt(" #n ")" ::: "memory")
#define PG8_WAIT_L(n) asm volatile("s_waitcnt lgkmcnt(" #n ")" ::: "memory")
#define PG8_BAR __builtin_amdgcn_s_barrier()
#define PG8_SCHED __builtin_amdgcn_sched_barrier(0)
    Unit cur, nxt; int ui = 0;
    if (!S.next(0, cur)) return;
    f32x4 acc[2][2][4][2];
#pragma unroll
    for (int a = 0; a < 2; ++a)
#pragma unroll
        for (int b = 0; b < 2; ++b)
#pragma unroll
            for (int m = 0; m < 4; ++m)
#pragma unroll
                for (int n = 0; n < 2; ++n) acc[a][b][m][n] = (f32x4){0.f, 0.f, 0.f, 0.f};
    h16x8 At[4][2], B0[2][2], B1[2][2];
    const char* cA = (const char*)g.A + (size_t)cur.pm * g.a_tile; const char* cB = (const char*)g.Bt + (size_t)cur.pn * g.b_tile + (size_t)cur.pm * g.b_pm_koff;
    S.a_ready(cur);
    if constexpr (SP2) {
        PG8_STAGE(PG8_SB(0, 0), cB, voffB); PG8_STAGE(PG8_SB(0, 1), cB + hstepB, voffB); PG8_STAGE(PG8_SA(0, 0), cA, voffA); PG8_STAGE(PG8_SA(0, 1), cA + hstepA, voffA);
        if (wr == 1) PG8_BAR;
        PG8_WAIT_V(2); PG8_BAR;
        PG8_STAGE(PG8_SB(1, 0), cB + kstep, voffB); PG8_STAGE(PG8_SA(1, 0), cA + kstep, voffA); PG8_STAGE(PG8_SB(1, 1), cB + hstepB + kstep, voffB);
        PG8_WAIT_V(6); PG8_BAR;
    } else {
        PG8_STAGE(PG8_SB(0, 0), cB, voffB); PG8_STAGE(PG8_SA(0, 0), cA, voffA); PG8_STAGE(PG8_SB(0, 1), cB + hstepB, voffB); PG8_STAGE(PG8_SA(0, 1), cA + hstepA, voffA);
        if (wr == 1) PG8_BAR;
        PG8_WAIT_V(4); PG8_BAR;
        PG8_STAGE(PG8_SB(1, 0), cB + kstep, voffB); PG8_STAGE(PG8_SA(1, 0), cA + kstep, voffA); PG8_STAGE(PG8_SB(1, 1), cB + hstepB + kstep, voffB);
        PG8_WAIT_V(6); PG8_BAR;
    }
    for (;;) {
        const bool has_next = S.next(ui + 1, nxt);
        const char* nA = has_next ? (const char*)g.A + (size_t)nxt.pm * g.a_tile : cA; const char* nB = has_next ? (const char*)g.Bt + (size_t)nxt.pn * g.b_tile + (size_t)nxt.pm * g.b_pm_koff : cB;
        for (int t = 0; t < nt; t += 2) {
            const bool last = (t == nt - 2);
            const char* a1 = cA + (size_t)(t + 1) * kstep;
            const char* a2 = last ? nA : cA + (size_t)(t + 2) * kstep; const char* b2 = last ? nB : cB + (size_t)(t + 2) * kstep;
            const char* a3 = a2 + kstep; const char* b3 = b2 + kstep;
            if (last && has_next) S.a_ready(nxt);
            if constexpr (SP2) {
            PG8_LDB(B0, 0, 0); PG8_LDB(B1, 0, 1); PG8_SCHED; PG8_LDA(At, 0, 0); PG8_STAGE(PG8_SA(1, 1), a1 + hstepA, voffA);
            PG8_WAIT_V(8); PG8_WAIT_L(0); PG8_BAR; PG8_MMA(0, 0, At, B0); PG8_MMA(0, 1, At, B1); PG8_BAR; PG8_SCHED;
            PG8_LDA(At, 0, 1); PG8_STAGE(PG8_SB(0, 0), b2, voffB); PG8_STAGE(PG8_SB(0, 1), b2 + hstepB, voffB); PG8_STAGE(PG8_SA(0, 0), a2, voffA);
            PG8_WAIT_V(8); PG8_WAIT_L(0); PG8_BAR; PG8_MMA(1, 0, At, B0); PG8_MMA(1, 1, At, B1); PG8_BAR; PG8_SCHED;
            PG8_LDB(B0, 1, 0); PG8_LDB(B1, 1, 1); PG8_SCHED; PG8_LDA(At, 1, 0); PG8_STAGE(PG8_SA(0, 1), a2 + hstepA, voffA);
            PG8_WAIT_V(8); PG8_WAIT_L(0); PG8_BAR; PG8_MMA(0, 0, At, B0); PG8_MMA(0, 1, At, B1); PG8_BAR; PG8_SCHED;
            PG8_LDA(At, 1, 1); PG8_STAGE(PG8_SB(1, 0), b3, voffB); PG8_STAGE(PG8_SB(1, 1), b3 + hstepB, voffB); PG8_STAGE(PG8_SA(1, 0), a3, voffA);
            PG8_WAIT_V(8); PG8_WAIT_L(0); PG8_BAR; PG8_MMA(1, 0, At, B0); PG8_MMA(1, 1, At, B1); PG8_BAR; PG8_SCHED;
            } else {
            PG8_LDB(B0, 0, 0); PG8_SCHED; PG8_LDA(At, 0, 0); PG8_STAGE(PG8_SA(1, 1), a1 + hstepA, voffA);
            PG8_WAIT_L(8); PG8_BAR; PG8_WAIT_L(0); PG8_MMA(0, 0, At, B0); PG8_BAR; PG8_SCHED;
            PG8_LDB(B1, 0, 1); PG8_STAGE(PG8_SB(0, 0), b2, voffB);
            PG8_BAR; PG8_WAIT_L(0); PG8_MMA(0, 1, At, B1); PG8_BAR;
            PG8_LDA(At, 0, 1); PG8_STAGE(PG8_SA(0, 0), a2, voffA);
            PG8_BAR; PG8_WAIT_L(0); PG8_MMA(1, 0, At, B0); PG8_BAR; PG8_SCHED;
            PG8_STAGE(PG8_SB(0, 1), b2 + hstepB, voffB);
            PG8_WAIT_V(6); PG8_BAR; PG8_MMA(1, 1, At, B1); PG8_BAR;
            PG8_LDB(B0, 1, 0); PG8_SCHED; PG8_LDA(At, 1, 0); PG8_STAGE(PG8_SA(0, 1), a2 + hstepA, voffA);
            PG8_WAIT_L(8); PG8_BAR; PG8_WAIT_L(0); PG8_MMA(0, 0, At, B0); PG8_BAR; PG8_SCHED;
            PG8_LDB(B1, 1, 1); PG8_STAGE(PG8_SB(1, 0), b3, voffB);
            PG8_BAR; PG8_WAIT_L(0); PG8_MMA(0, 1, At, B1); PG8_BAR;
            PG8_LDA(At, 1, 1); PG8_STAGE(PG8_SA(1, 0), a3, voffA);
            PG8_BAR; PG8_WAIT_L(0); PG8_MMA(1, 0, At, B0); PG8_BAR; PG8_SCHED;
            PG8_STAGE(PG8_SB(1, 1), b3 + hstepB, voffB);
            PG8_WAIT_V(6); PG8_BAR; PG8_MMA(1, 1, At, B1); PG8_BAR;
            }
        }
        if constexpr (ALIGN_EPI) { if (wr == 0) PG8_BAR; }
        if constexpr (!Epi::AFTER_DRAIN) { E(acc, cur, wr, wc, fr, fq); S.done(cur); }
        if (!has_next) break;
#pragma unroll
        for (int a = 0; a < 2; ++a)
#pragma unroll
            for (int b = 0; b < 2; ++b)
#pragma unroll
                for (int m = 0; m < 4; ++m)
#pragma unroll
                    for (int n = 0; n < 2; ++n) acc[a][b][m][n] = (f32x4){0.f, 0.f, 0.f, 0.f};
        cur = nxt; cA = nA; cB = nB; ++ui;
        if constexpr (ALIGN_EPI) { if (wr == 1) PG8_BAR; }
    }
    PG8_WAIT_V(0);
    if constexpr (!ALIGN_EPI) { if (wr == 0) PG8_BAR; }
    PG8_BAR;
    if constexpr (Epi::AFTER_DRAIN) { E.fused(acc, cur, wr, wc, fr, fq, lds, wid, lane); S.done(cur); }
#undef PG8_SA
#undef PG8_SB
#undef PG8_STAGE
#undef PG8_LDA
#undef PG8_LDB
#undef PG8_MMA
#undef PG8_WAIT_V
#undef PG8_WAIT_L
#undef PG8_BAR
#undef PG8_SCHED
}
}

using pg8::h16; using pg8::h16x8; using pg8::f32x4; using pg8::f32x2; using pg8::u32x4; using pg8::u32x2; using pg8::pk_h2;
#define LAS __attribute__((address_space(3)))
constexpr int NWAVES = 8;
constexpr int D = 1024, BATCH = 8, SEQ = 4096, M = BATCH * SEQ, FF = 2816, NH = 16, HD = 64;
constexpr float LN_EPS = 1e-5f;
constexpr size_t MiB = 1u << 20;
constexpr size_t WS_MOD = 0;
constexpr size_t WS_STATS = 1 * MiB;
constexpr size_t WS_DFT128 = 1 * MiB + 512 * 1024;
constexpr size_t WS_BAR = 1 * MiB + 768 * 1024;
constexpr size_t WS_WQK = 2 * MiB, WS_WV = 6 * MiB, WS_WO = 8 * MiB, WS_FWO = 10 * MiB, WS_WUP0 = 12 * MiB, WS_WUP1 = 23 * MiB, WS_WDN0 = 34 * MiB, WS_WDN1 = 34 * MiB + 5632 * 1024, WS_EDGE = 46 * MiB;
constexpr size_t WS_U = 80 * MiB, WS_ZA = 144 * MiB, WS_BIG = 272 * MiB, WS_END = 464 * MiB;
constexpr size_t WS_QK = WS_BIG, WS_VT = WS_BIG + 128 * MiB, WS_H = WS_BIG, WS_PQT = WS_BIG, WS_F = WS_BIG + 128 * MiB;
static_assert(WS_WDN1 + 5632 * 1024 <= WS_EDGE && WS_EDGE + (size_t)512 * 6 * 2816 * 4 <= WS_U, "ws map");
constexpr int LDS_BYTES = 152 * 1024;
constexpr int ATT_K_OFF = 0, ATT_V_OFF = 73728, ATT_VSTRIDE = 1160, ATT_B_OFF = ATT_V_OFF + 64 * ATT_VSTRIDE;
static_assert(ATT_B_OFF + 2048 <= LDS_BYTES, "lds map");
constexpr int N_PHASES = 18;
#define PROBE_MASK 0
#define PROBE_SYNC 0

struct Args { const float* in[16]; float* out; unsigned char* ws; int ph_lo, ph_hi, coop, pad; };

__device__ __forceinline__ float wave_sum(float v) {
#pragma unroll
    for (int o = 1; o < 64; o <<= 1) v += __shfl_xor(v, o);
    return v;
}
__device__ __forceinline__ int clipi(int v, int lo, int hi) { return v < lo ? lo : (v > hi ? hi : v); }

template <int KIND>
__device__ __forceinline__ void p0_transpose_item(const float* W, int ldw, int col0, int K, int ncols, h16* WT, LAS float* scr, int item, int lane) {
    const int nblk = ncols / 32, kb = item / nblk, nb = item % nblk, k0 = 64 * kb, n0 = 32 * nb;
#pragma unroll 8
    for (int i = 0; i < 32; ++i) { const int kk = 2 * i + (lane >> 5); scr[kk * 33 + (lane & 31)] = W[(size_t)(k0 + kk) * ldw + col0 + n0 + (lane & 31)]; }
    asm volatile("s_waitcnt lgkmcnt(0)" ::: "memory");
    const int c = lane & 7;
#pragma unroll
    for (int j = 0; j < 4; ++j) { const int n = (lane >> 3) + 8 * j; const LAS float* s = scr + (8 * c) * 33 + n;
        u32x4 o; o.x = pk_h2(s[0 * 33], s[1 * 33]); o.y = pk_h2(s[2 * 33], s[3 * 33]); o.z = pk_h2(s[4 * 33], s[5 * 33]); o.w = pk_h2(s[6 * 33], s[7 * 33]);
        int dr = n0 + n;
        if (KIND == 1) { const int f = dr % FF, isg = dr / FF; dr = (f >> 7) * 256 + isg * 128 + (f & 127); }
        *(u32x4*)(WT + (size_t)dr * K + k0 + 8 * c) = o; }
    asm volatile("s_waitcnt lgkmcnt(0)" ::: "memory");
}

template <int MODE, bool PERMROWS = false>
__device__ __forceinline__ void ln_rows(const float* src, const float* gam, const float* bet, const float* modsh, const float* modsc, h16* U, float* stats, float* outf, int G, int wid, int lane) {
    const int gw = blockIdx.x * NWAVES + wid, NGW = G * NWAVES;
    f32x4 gm[4], bt[4];
    if (MODE != 0) {
#pragma unroll
        for (int j = 0; j < 4; ++j) { gm[j] = *((const f32x4*)gam + lane + 64 * j); bt[j] = *((const f32x4*)bet + lane + 64 * j); }
    }
    for (int row = gw; row < M; row += NGW) {
        const int b = row >> 12;
        const f32x4* xr = (const f32x4*)(src + (size_t)row * D) + lane;
        f32x4 v[4];
#pragma unroll
        for (int j = 0; j < 4; ++j) v[j] = xr[64 * j];
        if (MODE != 0) {
            float s = 0.f;
#pragma unroll
            for (int j = 0; j < 4; ++j) s += (v[j].x + v[j].y) + (v[j].z + v[j].w);
            const float mean = wave_sum(s) * (1.f / D); float s2 = 0.f;
#pragma unroll
            for (int j = 0; j < 4; ++j) { v[j] = v[j] - mean; s2 += (v[j].x * v[j].x + v[j].y * v[j].y) + (v[j].z * v[j].z + v[j].w * v[j].w); }
            const float rstd = 1.f / sqrtf(wave_sum(s2) * (1.f / D) + LN_EPS);
            if (MODE == 1 && lane == 0) *(f32x2*)(stats + 2 * row) = (f32x2){mean, rstd};
#pragma unroll
            for (int j = 0; j < 4; ++j) v[j] = v[j] * rstd * gm[j] + bt[j];
        }
        if (MODE == 2) {
            f32x4* o = (f32x4*)(outf + (size_t)row * D) + lane;
#pragma unroll
            for (int j = 0; j < 4; ++j) o[64 * j] = v[j];
        } else {
            const f32x4* sh = (const f32x4*)(modsh + b * 6144) + lane; const f32x4* sc = (const f32x4*)(modsc + b * 6144) + lane;
            const int urow = PERMROWS ? ((row & ~4095) | ((row & 63) << 6) | ((row >> 6) & 63)) : row;
            u32x2* o8 = (u32x2*)(U + (size_t)urow * D) + lane;
#pragma unroll
            for (int j = 0; j < 4; ++j) { const f32x4 t = v[j] * (sc[64 * j] + 1.0f) + sh[64 * j]; u32x2 w; w.x = pk_h2(t.x, t.y); w.y = pk_h2(t.z, t.w); o8[64 * j] = w; }
        }
    }
}

__device__ __forceinline__ void ffn_fixup(const float* edge, const float* cw, const float* cb, h16* H, int G) {
    const int total = 512 * 2 * (FF / 4);
    int tid = threadIdx.x; asm volatile("" : "+v"(tid));
    for (int it = blockIdx.x * 512 + tid; it < total; it += G * 512) {
        const int f4 = it % (FF / 4), rest = it / (FF / 4), which = rest & 1, blk = rest >> 1, f = 4 * f4;
        const float* eb = edge + (size_t)blk * 6 * FF + f;
        f32x4 p, a, q, g; const f32x4 z4 = (f32x4){0.f, 0.f, 0.f, 0.f};
        if (which == 0) { p = ((blk & 63) == 0) ? z4 : *(const f32x4*)(eb - 6 * FF + 3 * FF); a = *(const f32x4*)(eb); q = *(const f32x4*)(eb + FF); g = *(const f32x4*)(eb + 4 * FF); }
        else { p = *(const f32x4*)(eb + 2 * FF); a = *(const f32x4*)(eb + 3 * FF); q = ((blk & 63) == 63) ? z4 : *(const f32x4*)(eb + 6 * FF); g = *(const f32x4*)(eb + 5 * FF); }
        const f32x4 w0 = *(const f32x4*)(cw + f), w1 = *(const f32x4*)(cw + FF + f), w2 = *(const f32x4*)(cw + 2 * FF + f), bb = *(const f32x4*)(cb + f);
        const f32x4 v = bb + w0 * p + w1 * a + w2 * q;
        const int row = blk * 64 + (which ? 63 : 0);
        u32x2 w; w.x = pk_h2(pg8::gelu_tanh(v.x) * g.x, pg8::gelu_tanh(v.y) * g.y); w.y = pk_h2(pg8::gelu_tanh(v.z) * g.z, pg8::gelu_tanh(v.w) * g.w);
        *(u32x2*)(H + (size_t)row * FF + f) = w;
    }
}

__device__ __forceinline__ void attn_phase(LAS unsigned char* lds, const h16* QK, const h16* VT, const float* rpb, h16* AO, int G, int tid, int wid, int lane) {
    LAS unsigned char* Kl = lds + ATT_K_OFF; LAS unsigned char* Vl = lds + ATT_V_OFF; LAS float* Bl = (LAS float*)(lds + ATT_B_OFF);
    const int l15 = lane & 15, fq = lane >> 4;
    for (int uid = blockIdx.x; uid < BATCH * NH * 32; uid += G) {
        const int rp = uid & 31, h = (uid >> 5) & 15, b = uid >> 9;
        const int r0 = 2 * rp, ulo = clipi(r0 - 4, 0, 56), uhi = clipi(r0 - 3, 0, 56) + 7, nrows = uhi - ulo + 1;
        {
            const h16* kg = QK + (size_t)(b * SEQ + ulo * 64) * 2048 + 1024 + h * 64;
            const h16* vg = VT + (size_t)(h * 64) * M + b * SEQ + ulo * 64;
            u32x4 kv[9];
#pragma unroll
            for (int it = 0; it < 9; ++it) { const int c = tid + 512 * it, tok = c >> 3, ch = c & 7;
                if (tok < nrows * 64) kv[it] = *(const u32x4*)(kg + (size_t)tok * 2048 + ch * 8); }
            if (tid < 465) Bl[tid] = rpb[h * 465 + tid];
#pragma unroll
            for (int it = 0; it < 9; ++it) { const int c = tid + 512 * it, tok = c >> 3, ch = c & 7;
                if (tok < nrows * 64) *(LAS u32x4*)(Kl + tok * 128 + ((ch ^ ((tok >> 1) & 7)) * 16)) = kv[it]; }
            asm volatile("" ::: "memory");
#pragma unroll
            for (int it = 0; it < 9; ++it) { const int c = tid + 512 * it, d = c / 72, ch = c % 72;
                if (ch < nrows * 8) kv[it] = *(const u32x4*)(vg + (size_t)d * M + ch * 8); }
#pragma unroll
            for (int it = 0; it < 9; ++it) { const int c = tid + 512 * it, d = c / 72, ch = c % 72;
                if (ch < nrows * 8) { LAS u32x2* p = (LAS u32x2*)(Vl + d * ATT_VSTRIDE + ch * 16); p[0] = (u32x2){kv[it].x, kv[it].y}; p[1] = (u32x2){kv[it].z, kv[it].w}; } }
        }
        __syncthreads();
        {
            const int qr = r0 + (wid >> 2), qcb = wid & 3, rs = clipi(qr - 4, 0, 56), srow0 = rs - ulo;
            const int cq = qcb * 16 + l15, cs = clipi(cq - 8, 0, 48);
            const h16* qp = QK + (size_t)(b * SEQ + qr * 64 + cq) * 2048 + h * 64 + fq * 8;
            const h16x8 q0 = *(const h16x8*)qp, q1 = *(const h16x8*)(qp + 32);
            float mx = -INFINITY;
#pragma unroll
            for (int i = 0; i < 8; ++i) {
#pragma unroll
                for (int t = 0; t < 3; ++t) {
                    const int kcb = qcb - 1 + t;
                    if (kcb >= 0 && kcb <= 3) {
                        const int tok = (srow0 + i) * 64 + kcb * 16 + l15, sw = (tok >> 1) & 7;
                        const LAS unsigned char* kp = Kl + tok * 128;
                        const h16x8 k0 = *(const LAS h16x8*)(kp + ((fq ^ sw) * 16)), k1 = *(const LAS h16x8*)(kp + (((4 + fq) ^ sw) * 16));
                        f32x4 a = (f32x4){0.f, 0.f, 0.f, 0.f};
                        a = __builtin_amdgcn_mfma_f32_16x16x32_f16(k0, q0, a, 0, 0, 0);
                        a = __builtin_amdgcn_mfma_f32_16x16x32_f16(k1, q1, a, 0, 0, 0);
                        const LAS float* brow = Bl + (rs + i - qr + 7) * 31;
#pragma unroll
                        for (int j = 0; j < 4; ++j) { const int kc = kcb * 16 + 4 * fq + j; const bool ok = (kc >= cs) && (kc < cs + 16); const int dc = clipi(kc - cq + 15, 0, 30);
                            const float v = ok ? a[j] + brow[dc] : -INFINITY; mx = fmaxf(mx, v); }
                    }
                }
                asm volatile("" ::: "memory");
            }
            mx = fmaxf(mx, __shfl_xor(mx, 16)); mx = fmaxf(mx, __shfl_xor(mx, 32));
            const float mb = mx * 1.44269504089f; float sum = 0.f;
            f32x4 o[4];
#pragma unroll
            for (int db = 0; db < 4; ++db) o[db] = (f32x4){0.f, 0.f, 0.f, 0.f};
#pragma unroll
            for (int i2 = 0; i2 < 4; ++i2) {
#pragma unroll
                for (int t = 0; t < 3; ++t) {
                    const int kcb = qcb - 1 + t;
                    if (kcb >= 0 && kcb <= 3) {
                        h16x8 p;
#pragma unroll
                        for (int e = 0; e < 2; ++e) {
                            const int i = 2 * i2 + e;
                            const int tok = (srow0 + i) * 64 + kcb * 16 + l15, sw = (tok >> 1) & 7;
                            const LAS unsigned char* kp = Kl + tok * 128;
                            const h16x8 k0 = *(const LAS h16x8*)(kp + ((fq ^ sw) * 16)), k1 = *(const LAS h16x8*)(kp + (((4 + fq) ^ sw) * 16));
                            f32x4 a = (f32x4){0.f, 0.f, 0.f, 0.f};
                            a = __builtin_amdgcn_mfma_f32_16x16x32_f16(k0, q0, a, 0, 0, 0);
                            a = __builtin_amdgcn_mfma_f32_16x16x32_f16(k1, q1, a, 0, 0, 0);
                            const LAS float* brow = Bl + (rs + i - qr + 7) * 31;
#pragma unroll
                            for (int j = 0; j < 4; ++j) { const int kc = kcb * 16 + 4 * fq + j; const bool ok = (kc >= cs) && (kc < cs + 16); const int dc = clipi(kc - cq + 15, 0, 30);
                                const float v = ok ? a[j] + brow[dc] : -INFINITY; const float pe = __builtin_amdgcn_exp2f(v * 1.44269504089f - mb); sum += pe; p[4 * e + j] = (h16)pe; }
                        }
                        const int tok0 = (srow0 + 2 * i2) * 64 + kcb * 16 + 4 * fq;
#pragma unroll
                        for (int db = 0; db < 4; ++db) {
                            const LAS unsigned char* vp = Vl + (db * 16 + l15) * ATT_VSTRIDE + tok0 * 2;
                            const u32x2 lo = *(const LAS u32x2*)vp, hi = *(const LAS u32x2*)(vp + 128);
                            const u32x4 vw = (u32x4){lo.x, lo.y, hi.x, hi.y};
                            o[db] = __builtin_amdgcn_mfma_f32_16x16x32_f16(__builtin_bit_cast(h16x8, vw), p, o[db], 0, 0, 0);
                        }
                    }
                    asm volatile("" ::: "memory");
                }
            }
            sum += __shfl_xor(sum, 16); sum += __shfl_xor(sum, 32);
            const float inv = 1.0f / sum;
            h16* op = AO + (size_t)(b * SEQ + qr * 64 + cq) * D + h * 64 + 4 * fq;
#pragma unroll
            for (int db = 0; db < 4; ++db) { const f32x4 v = o[db] * inv; u32x2 w; w.x = pk_h2(v.x, v.y); w.y = pk_h2(v.z, v.w); *(u32x2*)(op + db * 16) = w; }
        }
        __syncthreads();
    }
}

#define XB_TMO      128
#define XB_XCNT(j)  (256  + 64 * (j))
#define XB_XSUB(j)  (1280 + 64 * (j))
#define XB_XGEN(j)  (2304 + 64 * (j))
#define XB_TOP      3328
#define XB_TOPGEN   3392
#define XCD_BAR_WORDS 3456
#define XB_SPIN_CAP (1u << 18)

__device__ __forceinline__ unsigned xb_ld(unsigned* p)              { return __hip_atomic_load(p, __ATOMIC_RELAXED, __HIP_MEMORY_SCOPE_AGENT); }
__device__ __forceinline__ unsigned xb_add(unsigned* p, unsigned v) { return __hip_atomic_fetch_add(p, v, __ATOMIC_RELAXED, __HIP_MEMORY_SCOPE_AGENT); }
__device__ __forceinline__ unsigned xb_xcc_id() { return (unsigned)__builtin_amdgcn_s_getreg((3 << 11) | 20) & 0xFu; }
#define XB_SPIN(cond, bar) do { unsigned _sp = 0; while (cond) { __builtin_amdgcn_s_sleep(1); \
    if ((++_sp & 255u) == 0u) { if (xb_ld(&(bar)[XB_TMO])) break; if (_sp > XB_SPIN_CAP) { atomicAdd(&(bar)[XB_TMO], 1u); break; } } } } while (0)

struct XcdBarrier {
    unsigned* bar; unsigned x;
    volatile LAS unsigned* st;
};

__device__ __forceinline__ XcdBarrier xcd_barrier_post(unsigned* bar, volatile LAS unsigned* st) {
    XcdBarrier b; b.bar = bar; b.x = xb_xcc_id(); b.st = st;
    if (threadIdx.x == 0) (void)xb_add(&bar[XB_XCNT(b.x)], 1u);
    return b;
}
__device__ __forceinline__ void xcd_barrier_complete(unsigned* bar, unsigned x, unsigned& nloc, unsigned& nx) {
    const unsigned G = gridDim.x * gridDim.y * gridDim.z;
    unsigned sum, cnt, mine, sp = 0u;
    for (;;) {
        sum = 0u; cnt = 0u; mine = 0u;
#pragma unroll
        for (unsigned j = 0; j < 16; ++j) { const unsigned c = xb_ld(&bar[XB_XCNT(j)]); sum += c; cnt += (c > 0u) ? 1u : 0u; mine = (j == x) ? c : mine; }
        if (sum == G) break;
        __builtin_amdgcn_s_sleep(1);
        if ((++sp & 255u) == 0u) { if (xb_ld(&bar[XB_TMO])) break; if (sp > XB_SPIN_CAP) { atomicAdd(&bar[XB_TMO], 1u); break; } }
    }
    nloc = mine > 0u ? mine : 1u; nx = cnt > 0u ? cnt : 1u;
}

__device__ __forceinline__ void xcd_barrier(const XcdBarrier& b) {
    asm volatile("s_waitcnt vmcnt(0)" ::: "memory");
    __syncthreads();
    if (threadIdx.x == 0) {
        unsigned* bar = b.bar;
        __builtin_amdgcn_s_waitcnt(0);
        unsigned nloc = b.st[0], nx = b.st[1];
        if (nloc == 0u) { xcd_barrier_complete(bar, b.x, nloc, nx); b.st[0] = nloc; b.st[1] = nx; }
        const unsigned old = xb_add(&bar[XB_XSUB(b.x)], 1u);
        const unsigned gen = old / nloc;
        if (old + 1u == (gen + 1u) * nloc) {
            __builtin_amdgcn_fence(__ATOMIC_RELEASE, "agent");
            asm volatile("s_waitcnt vmcnt(0)" ::: "memory");
            const unsigned og = xb_add(&bar[XB_TOP], 1u);
            const unsigned tg = og / nx;
            if (og + 1u == (tg + 1u) * nx) xb_add(&bar[XB_TOPGEN], 1u);
            else XB_SPIN(xb_ld(&bar[XB_TOPGEN]) == tg, bar);
            __builtin_amdgcn_fence(__ATOMIC_ACQUIRE, "agent");
            xb_add(&bar[XB_XGEN(b.x)], 1u);
            asm volatile("s_waitcnt vmcnt(0)" ::: "memory");
        } else {
            XB_SPIN(xb_ld(&bar[XB_XGEN(b.x)]) == gen, bar);
            __builtin_amdgcn_fence(__ATOMIC_ACQUIRE, "agent");
            asm volatile("s_waitcnt vmcnt(0)" ::: "memory");
        }
    }
    __syncthreads();
}


constexpr int DF_TW_OFF = 0, DF_OM_OFF = 32768, DF_PHI_OFF = 65536, DF_OUT_OFF = 81920, DF_OUT_ROW = 136;
static_assert(DF_OUT_OFF + 8 * 64 * DF_OUT_ROW <= LDS_BYTES, "dft lds map");
__device__ __forceinline__ void dft2d_phase(LAS unsigned char* lds, const h16* PQT, h16* Y, int G, int tid, int wid, int lane) {
    LAS f32x2* TW = (LAS f32x2*)(lds + DF_TW_OFF);
    LAS unsigned char* OmL = lds + DF_OM_OFF;
    LAS unsigned char* Ol = lds + DF_OUT_OFF;
    const int n = lane & 15, kq = lane >> 4;
    for (int i = tid; i < 4096; i += 512) { float sn, cs; sincospif((float)i * (1.0f / 2048.0f), &sn, &cs); TW[i] = (f32x2){cs, sn}; }
    __syncthreads();
    for (int f = wid; f < 32; f += NWAVES) {
        const int nt = f >> 2, ks = f & 3, p = 16 * (nt >> 1) + n, rip = nt & 1, ri = ks >> 1;
        h16x8 v;
#pragma unroll
        for (int e = 0; e < 8; ++e) { const int a = 32 * (ks & 1) + 8 * kq + e; const f32x2 t = TW[((p * a) & 63) * 64];
            const float val = (rip == ri) ? t.x : (rip == 0 ? t.y : -t.y);
            v[e] = (h16)(val * 0.125f); }
        *(LAS h16x8*)(OmL + (f * 64 + lane) * 16) = v;
    }
    LAS unsigned char* PhL = lds + DF_PHI_OFF;
    for (int f = wid; f < 16; f += NWAVES) {
        const int qt = f >> 2, ks2 = f & 3, q = 16 * qt + n;
        h16x8 v;
#pragma unroll
        for (int e = 0; e < 8; ++e) { const int c = 32 * (ks2 & 1) + 16 * (e >> 2) + 4 * kq + (e & 3); const f32x2 t = TW[((q * c) & 63) * 64];
            v[e] = (h16)(((ks2 >> 1) ? t.y : t.x) * 0.125f); }
        *(LAS h16x8*)(PhL + (f * 64 + lane) * 16) = v;
    }
    __syncthreads();
    for (int it = blockIdx.x; it < 1024; it += G) {
        int cb = it;
        if (G == 256) { const int bx = it & 255, i = it >> 8, x = bx & 7, y = bx >> 3; cb = (x * 16 + (y >> 3) * 4 + i) * 8 + (y & 7); }
        const int b = cb >> 7, ch = (cb & 127) * 8 + wid;
        const h16* zp = PQT + (size_t)(b * 1024 + ch) * 8192 + n * 64 + 8 * kq;
        h16x8 zt[4][4];
#pragma unroll
        for (int ct = 0; ct < 4; ++ct)
#pragma unroll
            for (int ks = 0; ks < 4; ++ks) zt[ct][ks] = *(const h16x8*)(zp + (ks >> 1) * 4096 + ct * 1024 + (ks & 1) * 32);
#pragma unroll
        for (int pt = 0; pt < 4; ++pt) {
            f32x4 aR[4], aI[4];
#pragma unroll
            for (int ct = 0; ct < 4; ++ct) { aR[ct] = (f32x4){0.f, 0.f, 0.f, 0.f}; aI[ct] = (f32x4){0.f, 0.f, 0.f, 0.f}; }
#pragma unroll
            for (int ks = 0; ks < 4; ++ks) {
                const h16x8 bR = *(const LAS h16x8*)(OmL + (((2 * pt) * 4 + ks) * 64 + lane) * 16), bI = *(const LAS h16x8*)(OmL + (((2 * pt + 1) * 4 + ks) * 64 + lane) * 16);
#pragma unroll
                for (int ct = 0; ct < 4; ++ct) { aR[ct] = __builtin_amdgcn_mfma_f32_16x16x32_f16(zt[ct][ks], bR, aR[ct], 0, 0, 0); aI[ct] = __builtin_amdgcn_mfma_f32_16x16x32_f16(zt[ct][ks], bI, aI[ct], 0, 0, 0); }
            }
            const int p = 16 * pt + n;
            h16x8 tpR[2], tpI[2];
#pragma unroll
            for (int ct = 0; ct < 4; ++ct)
#pragma unroll
                for (int j = 0; j < 4; ++j) { const int c = 16 * ct + 4 * kq + j; const f32x2 t = TW[(c * p) & 4095];
                    const float tr = aR[ct][j], ti = aI[ct][j];
                    tpR[ct >> 1][4 * (ct & 1) + j] = (h16)(tr * t.x + ti * t.y); tpI[ct >> 1][4 * (ct & 1) + j] = (h16)(ti * t.x - tr * t.y); }
#pragma unroll
            for (int qt = 0; qt < 4; ++qt) {
                f32x4 d = (f32x4){0.f, 0.f, 0.f, 0.f};
                const LAS h16x8* ph = (const LAS h16x8*)(PhL + ((qt * 4) * 64 + lane) * 16);
                d = __builtin_amdgcn_mfma_f32_16x16x32_f16(tpR[0], ph[0], d, 0, 0, 0);
                d = __builtin_amdgcn_mfma_f32_16x16x32_f16(tpR[1], ph[64], d, 0, 0, 0);
                d = __builtin_amdgcn_mfma_f32_16x16x32_f16(tpI[0], ph[128], d, 0, 0, 0);
                d = __builtin_amdgcn_mfma_f32_16x16x32_f16(tpI[1], ph[192], d, 0, 0, 0);
                u32x2 w; w.x = pk_h2(d[0], d[1]); w.y = pk_h2(d[2], d[3]);
                *(LAS u32x2*)(Ol + (wid * 64 + 16 * qt + n) * DF_OUT_ROW + (16 * pt + 4 * kq) * 2) = w;
            }
            asm volatile("" ::: "memory");
        }
        __syncthreads();
        {
            h16* yb = Y + (size_t)(b * SEQ) * D + (cb & 127) * 8;
#pragma unroll
            for (int r = 0; r < 8; ++r) {
                const int k = tid + 512 * r, q = k >> 6, p = k & 63;
                unsigned short hv[8];
#pragma unroll
                for (int w = 0; w < 8; ++w) hv[w] = *(const LAS unsigned short*)(Ol + (w * 64 + q) * DF_OUT_ROW + p * 2);
                u32x4 o; o.x = hv[0] | ((unsigned)hv[1] << 16); o.y = hv[2] | ((unsigned)hv[3] << 16); o.z = hv[4] | ((unsigned)hv[5] << 16); o.w = hv[6] | ((unsigned)hv[7] << 16);
                *(u32x4*)(yb + (size_t)k * D) = o;
            }
        }
        __syncthreads();
    }
}

__global__ void __launch_bounds__(NWAVES * 64, 2) mega_fwd(Args args) {
    extern __shared__ __attribute__((aligned(16))) unsigned char lds_raw[];
    LAS unsigned char* lds = (LAS unsigned char*)lds_raw;
    cg::grid_group grid = cg::this_grid();
    const int G = gridDim.x;
#define PHASE_IDS int tid = threadIdx.x; asm volatile("" : "+v"(tid)); const int lane = tid & 63, wid = __builtin_amdgcn_readfirstlane(tid >> 6); (void)lane; (void)wid;
    unsigned char* ws = args.ws;
    const float* x = args.in[0]; const float* cvec = args.in[1]; const float* ada_w = args.in[2]; const float* ada_b = args.in[3];
    const float* w_qkv = args.in[4]; const float* rpb = args.in[5]; const float* na_wo = args.in[6]; const float* fn_wo = args.in[7];
    const float* ln1_g = args.in[8]; const float* ln1_b = args.in[9]; const float* w_up = args.in[10]; const float* conv_w = args.in[11];
    const float* conv_b = args.in[12]; const float* w_down = args.in[13]; const float* ln2_g = args.in[14]; const float* ln2_b = args.in[15];
    float* out = args.out;
    float* mod = (float*)(ws + WS_MOD); float* stats = (float*)(ws + WS_STATS);
    h16* DFT128 = (h16*)(ws + WS_DFT128);
    h16* Wqk_t = (h16*)(ws + WS_WQK); h16* Wv_t = (h16*)(ws + WS_WV); h16* Wo_t = (h16*)(ws + WS_WO); h16* Fwo_t = (h16*)(ws + WS_FWO);
    h16* Wup0 = (h16*)(ws + WS_WUP0); h16* Wup1 = (h16*)(ws + WS_WUP1); h16* Wdn0 = (h16*)(ws + WS_WDN0); h16* Wdn1 = (h16*)(ws + WS_WDN1);
    float* edge = (float*)(ws + WS_EDGE);
    h16* U = (h16*)(ws + WS_U); float* ZA = (float*)(ws + WS_ZA);
    h16* QKb = (h16*)(ws + WS_QK); h16* VTb = (h16*)(ws + WS_VT); h16* Hb = (h16*)(ws + WS_H); h16* PQT = (h16*)(ws + WS_PQT);

    const int lo = args.ph_lo, hi = args.ph_hi;
    unsigned* barw = (unsigned*)(ws + WS_BAR);
    volatile LAS unsigned* bst = (volatile LAS unsigned*)(lds + LDS_BYTES - 16);
    if (args.coop) {
        if (blockIdx.x == 0) for (int i = threadIdx.x; i < XCD_BAR_WORDS; i += NWAVES * 64) barw[i] = 0u;
        if (threadIdx.x < 2) bst[threadIdx.x] = 0u;
        __syncthreads();
    }
    XcdBarrier xbar; xbar.bar = barw; xbar.x = 0; xbar.st = bst;
#define IN(k) (lo <= (k) && (k) < hi)
#define SEAM(k) do { if (IN(k) && IN((k) + 1)) { xcd_barrier(xbar); if (PROBE_SYNC) xcd_barrier(xbar); } } while (0)
#define REPS(k) _Pragma("unroll 1") for (int rep_ = 0; rep_ < ((PROBE_MASK >> (k)) & 1) + 1; ++rep_)
    const size_t T1K = (size_t)256 * 1024 * 2;

    if (IN(0)) REPS(0) { PHASE_IDS
        LAS float* scr = (LAS float*)(lds + wid * 8448);
        const int gw = blockIdx.x * NWAVES + wid, NGW = G * NWAVES;
        constexpr int I_QK = 16 * 64, I_V = 16 * 32, I_O = 16 * 32, I_UP = 16 * 176, I_DN = 44 * 32;
        constexpr int NITEMS = I_QK + I_V + 2 * I_O + 2 * I_UP + 2 * I_DN;
        for (int it = gw; it < NITEMS; it += NGW) {
            int r = it;
            if (r < I_QK) { p0_transpose_item<0>(w_qkv, 3072, 0, 1024, 2048, Wqk_t, scr, r, lane); continue; } r -= I_QK;
            if (r < I_V) { p0_transpose_item<0>(w_qkv, 3072, 2048, 1024, 1024, Wv_t, scr, r, lane); continue; } r -= I_V;
            if (r < I_O) { p0_transpose_item<0>(na_wo, 1024, 0, 1024, 1024, Wo_t, scr, r, lane); continue; } r -= I_O;
            if (r < I_O) { p0_transpose_item<0>(fn_wo, 1024, 0, 1024, 1024, Fwo_t, scr, r, lane); continue; } r -= I_O;
            if (r < I_UP) { p0_transpose_item<1>(w_up, 5632, 0, 1024, 5632, Wup0, scr, r, lane); continue; } r -= I_UP;
            if (r < I_UP) { p0_transpose_item<1>(w_up + (size_t)1024 * 5632, 5632, 0, 1024, 5632, Wup1, scr, r, lane); continue; } r -= I_UP;
            if (r < I_DN) { p0_transpose_item<0>(w_down, 1024, 0, 2816, 1024, Wdn0, scr, r, lane); continue; } r -= I_DN;
            p0_transpose_item<0>(w_down + (size_t)2816 * 1024, 1024, 0, 2816, 1024, Wdn1, scr, r, lane);
        }
        for (int e = blockIdx.x * 512 + tid; e < 256 * 128; e += G * 512) {
            const int row = e >> 7, c = e & 127, ri = row >> 7, m = row & 127; const float ph = (float)((m * c) & 127) * (1.0f / 128.0f);
            const float v = (ri ? -__builtin_amdgcn_sinf(ph) : __builtin_amdgcn_cosf(ph)) * 0.08838834764831845f;
            DFT128[e] = (h16)v;
        }
        __syncthreads();
        LAS float* cs = (LAS float*)(lds + 80 * 1024);
        LAS float* red = (LAS float*)(lds + 112 * 1024);
        if (blockIdx.x < 192) {
            for (int i = tid; i < 8 * 1024; i += 512) { const float v = cvec[i]; cs[i] = v / (1.0f + __expf(-v)); }
            __syncthreads();
            for (int it = blockIdx.x; it < 192; it += G) {
                const int li = it / 96, e0 = (it % 96) * 64;
                const float* wp = ada_w + (size_t)li * 1024 * 6144 + (size_t)(wid * 128) * 6144 + e0 + lane;
                float a[8];
#pragma unroll
                for (int b = 0; b < 8; ++b) a[b] = 0.f;
#pragma unroll 8
                for (int d = 0; d < 128; ++d) { const float w = wp[(size_t)d * 6144];
#pragma unroll
                    for (int b = 0; b < 8; ++b) a[b] += w * cs[b * 1024 + wid * 128 + d]; }
#pragma unroll
                for (int b = 0; b < 8; ++b) red[(wid * 8 + b) * 64 + lane] = a[b];
                __syncthreads();
                { const int b = tid >> 6, col = tid & 63; float s = ada_b[li * 6144 + e0 + col];
#pragma unroll
                  for (int w = 0; w < 8; ++w) s += red[(w * 8 + b) * 64 + col];
                  mod[(size_t)(li * 8 + b) * 6144 + e0 + col] = s; }
                __syncthreads();
            }
        }
    }
    if (IN(0) && IN(1)) { grid.sync(); xbar = xcd_barrier_post(barw, bst); }
    const float* mod0 = mod; const float* mod1 = mod + 8 * 6144;

    if (IN(1)) REPS(1) { PHASE_IDS ln_rows<0>(x, nullptr, nullptr, mod0 + 0 * 1024, mod0 + 1 * 1024, U, nullptr, nullptr, G, wid, lane); }
    SEAM(1);
    if (IN(2)) REPS(2) {
        { pg8::Gemm g{U, Wqk_t, 1024, 1024, 1024, T1K, T1K, 0}; pg8::StaticOrder S; S.init(M, 2048, G, (int)blockIdx.x);
          pg8::EpiH16 E{QKb, 2048, 0, 0, 1024, 0.125f};
          pg8::gemm_phase<pg8::EpiH16, pg8::StaticOrder, true, true>(lds, g, S, E); }
        { pg8::Gemm g{Wv_t, U, 1024, 1024, 1024, T1K, T1K, 0}; pg8::StaticOrder S; S.init(1024, M, G, (int)blockIdx.x);
          pg8::EpiH16 E{VTb, M, 0, 0, 0, 1.f};
          pg8::gemm_phase<pg8::EpiH16, pg8::StaticOrder, true, true>(lds, g, S, E); }
    }
    SEAM(2);
    if (IN(3)) REPS(3) { PHASE_IDS attn_phase(lds, QKb, VTb, rpb, U, G, tid, wid, lane); }
    SEAM(3);
    if (IN(4)) REPS(4) { pg8::Gemm g{U, Wo_t, 1024, 1024, 1024, T1K, T1K, 0}; pg8::StaticOrder S; S.init(M, 1024, G, (int)blockIdx.x);
        pg8::EpiRes E{x, nullptr, nullptr, nullptr, mod0 + 2 * 1024, ZA};
        pg8::gemm_phase<pg8::EpiRes, pg8::StaticOrder, true, true>(lds, g, S, E); }
    SEAM(4);
#pragma unroll
    for (int L = 0; L < 2; ++L) {
        const int pb = (L == 0) ? 5 : 13;
        const float* modL = L ? mod1 : mod0;
        if (IN(pb)) REPS(pb) { PHASE_IDS ln_rows<1>(ZA, ln1_g + L * 1024, ln1_b + L * 1024, modL + 3 * 1024, modL + 4 * 1024, U, stats, nullptr, G, wid, lane); }
        SEAM(pb);
        if (IN(pb + 1)) REPS(pb + 1) { pg8::Gemm g{U, L ? Wup1 : Wup0, 1024, 1024, 1024, T1K, T1K, 0}; pg8::StaticOrder S; S.init(M, 2 * FF, G, (int)blockIdx.x);
            pg8::EpiUp E{conv_w + (size_t)L * 3 * FF, conv_b + L * FF, Hb, edge};
            pg8::gemm_phase<pg8::EpiUp, pg8::StaticOrder, true, true>(lds, g, S, E); }
        SEAM(pb + 1);
        if (IN(pb + 2)) REPS(pb + 2) ffn_fixup(edge, conv_w + (size_t)L * 3 * FF, conv_b + L * FF, Hb, G);
        SEAM(pb + 2);
        if (IN(pb + 3)) REPS(pb + 3) { pg8::Gemm g{Hb, L ? Wdn1 : Wdn0, FF, FF, FF, (size_t)256 * FF * 2, (size_t)256 * FF * 2, 0}; pg8::StaticOrder S; S.init(M, 1024, G, (int)blockIdx.x);
            pg8::EpiRes E{ZA, stats, ln1_g + L * 1024, ln1_b + L * 1024, modL + 5 * 1024, out};
            pg8::gemm_phase<pg8::EpiRes, pg8::StaticOrder, true, true>(lds, g, S, E); }
        SEAM(pb + 3);
        if (L == 0) {
            if (IN(9)) REPS(9) { PHASE_IDS
                ln_rows<1, true>(out, ln2_g, ln2_b, mod1 + 0 * 1024, mod1 + 1 * 1024, U, stats, nullptr, G, wid, lane);
            }
            SEAM(9);
            if (IN(10)) REPS(10) { int k128 = 128; asm volatile("" : "+s"(k128)); pg8::Gemm g{DFT128, U, 128, 1024, k128, 0, T1K, 256}; pg8::StaticOrder S; S.init(8 * 256, M, G, (int)blockIdx.x);
                pg8::EpiF1 E{PQT};
                pg8::gemm_phase<pg8::EpiF1, pg8::StaticOrder, true, true>(lds, g, S, E); }
            SEAM(10);
            if (IN(11)) REPS(11) { PHASE_IDS dft2d_phase(lds, PQT, U, G, tid, wid, lane); }
            SEAM(11);
            if (IN(12)) REPS(12) { pg8::Gemm g{U, Fwo_t, 1024, 1024, 1024, T1K, T1K, 0}; pg8::StaticOrder S; S.init(M, 1024, G, (int)blockIdx.x);
                pg8::EpiRes E{out, stats, ln2_g, ln2_b, mod1 + 2 * 1024, ZA};
                pg8::gemm_phase<pg8::EpiRes, pg8::StaticOrder, true, true>(lds, g, S, E); }
            SEAM(12);
        }
    }
    if (IN(17)) REPS(17) { PHASE_IDS ln_rows<2>(out, ln2_g + 1024, ln2_b + 1024, nullptr, nullptr, nullptr, nullptr, out, G, wid, lane); }
#undef IN
#undef SEAM
}

extern "C" void kernel_launch(void* const* d_in, const int* in_sizes, int n_in, void* d_out, int out_size, void* d_ws, size_t ws_size, hipStream_t stream) {
    static int grid = 0;
    if (grid == 0) {
        if (n_in != 16 || out_size != M * D || ws_size < WS_END) { fprintf(stderr, "kernel_launch: unexpected shapes (n_in %d out %d ws %zu)\n", n_in, out_size, ws_size); grid = -1; return; }
        int dev = 0, cus = 0, per_cu = 0;
        hipGetDevice(&dev); hipDeviceGetAttribute(&cus, hipDeviceAttributeMultiprocessorCount, dev);
        if (hipFuncSetAttribute((const void*)mega_fwd, hipFuncAttributeMaxDynamicSharedMemorySize, LDS_BYTES) != hipSuccess) { fprintf(stderr, "kernel_launch: hipFuncSetAttribute failed\n"); grid = -1; return; }
        if (hipOccupancyMaxActiveBlocksPerMultiprocessor(&per_cu, (const void*)mega_fwd, NWAVES * 64, LDS_BYTES) != hipSuccess || per_cu < 1) { fprintf(stderr, "kernel_launch: occupancy query says %d\n", per_cu); per_cu = 1; }
        (void)hipGetLastError();
        grid = cus;
        fprintf(stderr, "kernel_launch: grid %d (cus %d, per_cu %d)\n", grid, cus, per_cu);
    }
    if (grid < 0) return;
    Args a{};
    for (int i = 0; i < 16; ++i) a.in[i] = (const float*)d_in[i];
    a.out = (float*)d_out; a.ws = (unsigned char*)d_ws;
#if MK_ONE_LAUNCH
    a.ph_lo = 0; a.ph_hi = N_PHASES; a.coop = 1;
    void* kargs[] = {&a};
    hipError_t e = hipLaunchCooperativeKernel((const void*)mega_fwd, dim3(grid), dim3(NWAVES * 64), kargs, LDS_BYTES, stream);
    if (e != hipSuccess) fprintf(stderr, "cooperative launch failed: %s (grid %d)\n", hipGetErrorString(e), grid);
#else
    for (int p = 0; p < N_PHASES; ++p) { a.ph_lo = p; a.ph_hi = p + 1; a.coop = 0;
        hipLaunchKernelGGL(mega_fwd, dim3(grid), dim3(NWAVES * 64), LDS_BYTES, stream, a); }
#endif
}
```

```cpp
#include <hip/hip_runtime.h>
#include <hip/hip_cooperative_groups.h>
#include <cstdio>
#include <cstdint>
namespace cg = cooperative_groups;

#ifndef MK_ONE_LAUNCH
#define MK_ONE_LAUNCH 1
#endif

namespace pg8 {
#define PG8_LAS __attribute__((address_space(3)))
typedef _Float16 h16;
typedef _Float16 h16x8 __attribute__((ext_vector_type(8)));
typedef _Float16 h16x2 __attribute__((ext_vector_type(2)));
typedef float f32x4 __attribute__((ext_vector_type(4)));
typedef float f32x2 __attribute__((ext_vector_type(2)));
typedef unsigned u32x4 __attribute__((ext_vector_type(4)));
typedef unsigned u32x2 __attribute__((ext_vector_type(2)));
constexpr int BM = 256, BK = 64, HALF = 128, HTB = HALF * BK * 2  , STAGE_BYTES = 8 * HTB, NXCD = 8, WGM = 8;

__host__ __device__ __forceinline__ int lds_byte(int r, int c) { const int st = (r >> 4) * 2 + (c >> 5), rr = r & 15, cc = c & 31, ob = rr * 64 + cc * 2; return st * 1024 + (ob ^ (((ob >> 9) & 1) << 5)); }
__host__ __device__ __forceinline__ void stage_rc(int b, int& R, int& C) { const int st = b / 1024, sb = b % 1024, swz = sb ^ (((sb >> 9) & 1) << 5); R = (st >> 1) * 16 + swz / 64; C = (st & 1) * 32 + (swz % 64) / 2; }
__host__ __device__ __forceinline__ int perm32(int rho) { const int n = rho >> 4, i = rho & 15; return 8 * (i >> 2) + 4 * n + (i & 3); }

struct Unit { int pm, pn; };
struct Gemm { const h16* A; const h16* Bt; int lda, ldb, K; size_t a_tile, b_tile, b_pm_koff; };

struct StaticOrder {
    int nM, nN, nwg, G, c;
    __host__ __device__ void init(int M, int N, int G_, int c_) { nM = M / BM; nN = N / BM; nwg = nM * nN; G = G_; c = c_; }
    __host__ __device__ bool next(int i, Unit& u) const {
        const long L = (long)i * G + c; if (L >= nwg) return false;
        int wgid = (int)L; { const int q = nwg / NXCD, r = nwg % NXCD, xcd = wgid % NXCD, off = wgid / NXCD; wgid = (xcd < r ? xcd * (q + 1) : r * (q + 1) + (xcd - r) * q) + off; }
        const int nig = WGM * nN, gid = wgid / nig, fm = gid * WGM, gsz = (nM - fm) < WGM ? (nM - fm) : WGM;
        u.pm = fm + ((wgid % nig) % gsz); u.pn = (wgid % nig) / gsz; return true;
    }
    __device__ __forceinline__ void a_ready(const Unit&) const {}
    __device__ __forceinline__ void done(const Unit&) const {}
};

__device__ __forceinline__ unsigned pk_h2(float lo, float hi) { h16x2 v; v.x = (h16)lo; v.y = (h16)hi; return __builtin_bit_cast(unsigned, v); }


struct EpiH16 {
    static constexpr bool PERM = true, AFTER_DRAIN = false;
    h16* O; int ldc; int split_cols; size_t split_stride; int scale_cols; float scale;
    __device__ __forceinline__ void operator()(const f32x4 (&acc)[2][2][4][2], const Unit& u, int wr, int wc, int fr, int fq) const {
        const int row0 = u.pm * BM + wr * 64 + fr; int colt = u.pn * BM; h16* base = O;
        const float sc = (colt < scale_cols) ? scale : 1.f;
        if (split_cols) { const int t = colt / split_cols; base += (size_t)t * split_stride; colt -= t * split_cols; }
        const int col0 = colt + wc * 32 + 8 * fq;
#pragma unroll
        for (int ai = 0; ai < 2; ++ai)
#pragma unroll
            for (int m = 0; m < 4; ++m) { h16* rowp = base + (size_t)(row0 + ai * HALF + m * 16) * ldc + col0;
#pragma unroll
                for (int bj = 0; bj < 2; ++bj) { const f32x4 v0 = acc[ai][bj][m][0] * sc, v1 = acc[ai][bj][m][1] * sc;
                    u32x4 w; w.x = pk_h2(v0[0], v0[1]); w.y = pk_h2(v0[2], v0[3]); w.z = pk_h2(v1[0], v1[1]); w.w = pk_h2(v1[2], v1[3]);
                    *(u32x4*)(rowp + bj * HALF) = w; } }
    }
};

struct EpiF1 {
    static constexpr bool PERM = true, AFTER_DRAIN = false;
    h16* PQT;
    __device__ __forceinline__ void operator()(const f32x4 (&acc)[2][2][4][2], const Unit& u, int wr, int wc, int fr, int fq) const {
        const int b = u.pn >> 4, s0 = (u.pn & 15) * 256 + wc * 32 + 8 * fq;
#pragma unroll
        for (int ai = 0; ai < 2; ++ai)
#pragma unroll
            for (int m = 0; m < 4; ++m) { h16* rowp = PQT + (size_t)(b * 1024 + u.pm * 128 + wr * 64 + m * 16 + fr) * 8192 + ai * 4096 + s0;
#pragma unroll
                for (int bj = 0; bj < 2; ++bj) { const f32x4 v0 = acc[ai][bj][m][0], v1 = acc[ai][bj][m][1];
                    u32x4 w; w.x = pk_h2(v0[0], v0[1]); w.y = pk_h2(v0[2], v0[3]); w.z = pk_h2(v1[0], v1[1]); w.w = pk_h2(v1[2], v1[3]);
                    *(u32x4*)(rowp + bj * HALF) = w; } }
    }
};

struct EpiRes {
    static constexpr bool PERM = false, AFTER_DRAIN = false;
    const float* res; const float* stats; const float* gam; const float* bet; const float* gate; float* out;
    __device__ __forceinline__ void operator()(const f32x4 (&acc)[2][2][4][2], const Unit& u, int wr, int wc, int fr, int fq) const {
        const int b = u.pm >> 4; const float ALPHA = 1.41421356237f;
#pragma unroll
        for (int bj = 0; bj < 2; ++bj)
#pragma unroll
            for (int n = 0; n < 2; ++n) {
                const int col = u.pn * BM + bj * HALF + wc * 32 + n * 16 + 4 * fq;
                const f32x4 gt = *(const f32x4*)(gate + b * 6144 + col) + 1.0f;
                f32x4 gm = (f32x4){1.f, 1.f, 1.f, 1.f}, bt = (f32x4){0.f, 0.f, 0.f, 0.f};
                if (stats) { gm = *(const f32x4*)(gam + col); bt = *(const f32x4*)(bet + col); }
#pragma unroll
                for (int ai = 0; ai < 2; ++ai)
#pragma unroll
                    for (int m = 0; m < 4; ++m) {
                        const int row = u.pm * BM + ai * HALF + wr * 64 + m * 16 + fr;
                        f32x4 r = *(const f32x4*)(res + (size_t)row * 1024 + col);
                        if (stats) { const f32x2 st = *(const f32x2*)(stats + 2 * row); r = (r - st.x) * st.y * gm + bt; }
                        const f32x4 o = r * ALPHA + gt * acc[ai][bj][m][n];
                        *(f32x4*)(out + (size_t)row * 1024 + col) = o;
                    }
            }
    }
};

__device__ __forceinline__ float dpp_prev(float old, float src) {
    return __builtin_bit_cast(float, __builtin_amdgcn_update_dpp(__builtin_bit_cast(int, old), __builtin_bit_cast(int, src), 0x111, 0xf, 0xf, false)); }
__device__ __forceinline__ float dpp_next(float old, float src) {
    return __builtin_bit_cast(float, __builtin_amdgcn_update_dpp(__builtin_bit_cast(int, old), __builtin_bit_cast(int, src), 0x101, 0xf, 0xf, false)); }
__device__ __forceinline__ float dpp_ror1(float src) {
    return __builtin_bit_cast(float, __builtin_amdgcn_update_dpp(0, __builtin_bit_cast(int, src), 0x121, 0xf, 0xf, false)); }
__device__ __forceinline__ float dpp_ror15(float src) {
    return __builtin_bit_cast(float, __builtin_amdgcn_update_dpp(0, __builtin_bit_cast(int, src), 0x12f, 0xf, 0xf, false)); }
__device__ __forceinline__ float gelu_tanh(float v) {
    const float y = v + 0.044715f * v * v * v;
    const float e = __builtin_amdgcn_exp2f(-2.302208198f * y);
    return v * __builtin_amdgcn_rcpf(1.0f + e);
}

struct EpiUp {
    static constexpr bool PERM = true, AFTER_DRAIN = false;
    const float* cw; const float* cb; h16* H; float* edge;
    __device__ __forceinline__ void operator()(const f32x4 (&acc)[2][2][4][2], const Unit& u, int wr, int wc, int fr, int fq) const {
        const int f0 = u.pn * 128 + wc * 32 + 8 * fq;
        f32x4 w0[2], w1[2], w2[2], bb[2];
#pragma unroll
        for (int n = 0; n < 2; ++n) { w0[n] = *(const f32x4*)(cw + f0 + 4 * n); w1[n] = *(const f32x4*)(cw + 2816 + f0 + 4 * n); w2[n] = *(const f32x4*)(cw + 2 * 2816 + f0 + 4 * n); bb[n] = *(const f32x4*)(cb + f0 + 4 * n); }
#pragma unroll
        for (int ai = 0; ai < 2; ++ai) {
            const int blk = u.pm * 4 + ai * 2 + wr;
            float* eb = edge + (size_t)blk * 6 * 2816 + f0;
#pragma unroll
            for (int m = 0; m < 4; ++m) {
                unsigned pk[4];
#pragma unroll
                for (int n = 0; n < 2; ++n) {
                    const f32x4 a = acc[ai][0][m][n], g = acc[ai][1][m][n];
                    f32x4 hv;
#pragma unroll
                    for (int j = 0; j < 4; ++j) {
                        const float po = (m > 0) ? dpp_ror1(acc[ai][0][m > 0 ? m - 1 : 0][n][j]) : 0.f;
                        const float no = (m < 3) ? dpp_ror15(acc[ai][0][m < 3 ? m + 1 : 3][n][j]) : 0.f;
                        const float p = dpp_prev(po, a[j]), q = dpp_next(no, a[j]);
                        const float v = bb[n][j] + w0[n][j] * p + w1[n][j] * a[j] + w2[n][j] * q;
                        hv[j] = gelu_tanh(v) * g[j];
                    }
                    pk[2 * n] = pk_h2(hv[0], hv[1]); pk[2 * n + 1] = pk_h2(hv[2], hv[3]);
                    if (m == 0) { if (fr == 0) { *(f32x4*)(eb + 0 * 2816 + 4 * n) = a; *(f32x4*)(eb + 4 * 2816 + 4 * n) = g; } if (fr == 1) *(f32x4*)(eb + 1 * 2816 + 4 * n) = a; }
                    if (m == 3) { if (fr == 14) *(f32x4*)(eb + 2 * 2816 + 4 * n) = a; if (fr == 15) { *(f32x4*)(eb + 3 * 2816 + 4 * n) = a; *(f32x4*)(eb + 5 * 2816 + 4 * n) = g; } }
                }
                const int row = u.pm * BM + ai * HALF + wr * 64 + m * 16 + fr;
                u32x4 w; w.x = pk[0]; w.y = pk[1]; w.z = pk[2]; w.w = pk[3];
                *(u32x4*)(H + (size_t)row * 2816 + f0) = w;
            }
        }
    }
};

template <class Epi, class Sched, bool ALIGN_EPI = false, bool SP2 = false>
__device__ __forceinline__ void gemm_phase(PG8_LAS unsigned char* lds, const Gemm g, const Sched& S, const Epi& E) {
    int tid_ = threadIdx.x; asm volatile("" : "+v"(tid_));
    const int tid = tid_, wid = __builtin_amdgcn_readfirstlane(tid >> 6), lane = tid & 63, wr = wid >> 2, wc = wid & 3, fr = lane & 15, fq = lane >> 4;
    const int K = g.K, nt = K / BK;
    unsigned voffA[2], voffB[2];
#pragma unroll
    for (int i = 0; i < 2; ++i) { int R, C; stage_rc(tid * 16 + i * 8192, R, C); const int Rb = Epi::PERM ? ((R & ~31) + perm32(R & 31)) : R;
        voffA[i] = (unsigned)(R * g.lda + C) * 2u; voffB[i] = (unsigned)(Rb * g.ldb + C) * 2u; }
    const size_t kstep = (size_t)(BK * 2);
    const size_t hstepA = (size_t)HALF * g.lda * 2, hstepB = (size_t)HALF * g.ldb * 2;
    const unsigned ldsw = (unsigned)wid * 1024u;
    const int aoff = lds_byte(wr * 64 + fr, fq * 8), boff = lds_byte(wc * 32 + fr, fq * 8);
#define PG8_SA(b, h) (((b) * 2 + (h)) * HTB)
#define PG8_SB(b, h) ((4 + (b) * 2 + (h)) * HTB)
#define PG8_STAGE(bufoff, gbase, voff) do { _Pragma("unroll") for (int _i = 0; _i < 2; ++_i) \
        __builtin_amdgcn_global_load_lds((const unsigned*)((const char*)(gbase) + (voff)[_i]), (PG8_LAS unsigned*)(lds + (bufoff) + ldsw + _i * 8192), 16, 0, 0); } while (0)
#define PG8_LDA(dst, b, h) do { _Pragma("unroll") for (int m = 0; m < 4; ++m) _Pragma("unroll") for (int k = 0; k < 2; ++k) dst[m][k] = *(const PG8_LAS h16x8*)(lds + PG8_SA(b, h) + aoff + m * 2048 + k * 1024); } while (0)
#define PG8_LDB(dst, b, h) do { _Pragma("unroll") for (int n = 0; n < 2; ++n) _Pragma("unroll") for (int k = 0; k < 2; ++k) dst[n][k] = *(const PG8_LAS h16x8*)(lds + PG8_SB(b, h) + boff + n * 2048 + k * 1024); } while (0)
#define PG8_MMA(ai, bj, At, Bt) do { __builtin_amdgcn_s_setprio(1); _Pragma("unroll") for (int m = 0; m < 4; ++m) _Pragma("unroll") for (int n = 0; n < 2; ++n) _Pragma("unroll") for (int k = 0; k < 2; ++k) \
        acc[ai][bj][m][n] = __builtin_amdgcn_mfma_f32_16x16x32_f16(Bt[n][k], At[m][k], acc[ai][bj][m][n], 0, 0, 0); __builtin_amdgcn_s_setprio(0); } while (0)
#define PG8_WAIT_V(n) asm volatile("s_waitcnt vmcnt(" #n ")" ::: "memory")
#define PG8_WAIT_L(n) asm volatile("s_waitcnt lgkmcnt(" #n ")" ::: "memory")
#define PG8_BAR __builtin_amdgcn_s_barrier()
#define PG8_SCHED __builtin_amdgcn_sched_barrier(0)
    Unit cur, nxt; int ui = 0;
    if (!S.next(0, cur)) return;
    f32x4 acc[2][2][4][2];
#pragma unroll
    for (int a = 0; a < 2; ++a)
#pragma unroll
        for (int b = 0; b < 2; ++b)
#pragma unroll
            for (int m = 0; m < 4; ++m)
#pragma unroll
                for (int n = 0; n < 2; ++n) acc[a][b][m][n] = (f32x4){0.f, 0.f, 0.f, 0.f};
    h16x8 At[4][2], B0[2][2], B1[2][2];
    const char* cA = (const char*)g.A + (size_t)cur.pm * g.a_tile; const char* cB = (const char*)g.Bt + (size_t)cur.pn * g.b_tile + (size_t)cur.pm * g.b_pm_koff;
    S.a_ready(cur);
    if constexpr (SP2) {
        PG8_STAGE(PG8_SB(0, 0), cB, voffB); PG8_STAGE(PG8_SB(0, 1), cB + hstepB, voffB); PG8_STAGE(PG8_SA(0, 0), cA, voffA); PG8_STAGE(PG8_SA(0, 1), cA + hstepA, voffA);
        if (wr == 1) PG8_BAR;
        PG8_WAIT_V(2); PG8_BAR;
        PG8_STAGE(PG8_SB(1, 0), cB + kstep, voffB); PG8_STAGE(PG8_SA(1, 0), cA + kstep, voffA); PG8_STAGE(PG8_SB(1, 1), cB + hstepB + kstep, voffB);
        PG8_WAIT_V(6); PG8_BAR;
    } else {
        PG8_STAGE(PG8_SB(0, 0), cB, voffB); PG8_STAGE(PG8_SA(0, 0), cA, voffA); PG8_STAGE(PG8_SB(0, 1), cB + hstepB, voffB); PG8_STAGE(PG8_SA(0, 1), cA + hstepA, voffA);
        if (wr == 1) PG8_BAR;
        PG8_WAIT_V(4); PG8_BAR;
        PG8_STAGE(PG8_SB(1, 0), cB + kstep, voffB); PG8_STAGE(PG8_SA(1, 0), cA + kstep, voffA); PG8_STAGE(PG8_SB(1, 1), cB + hstepB + kstep, voffB);
        PG8_WAIT_V(6); PG8_BAR;
    }
    for (;;) {
        const bool has_next = S.next(ui + 1, nxt);
        const char* nA = has_next ? (const char*)g.A + (size_t)nxt.pm * g.a_tile : cA; const char* nB = has_next ? (const char*)g.Bt + (size_t)nxt.pn * g.b_tile + (size_t)nxt.pm * g.b_pm_koff : cB;
        for (int t = 0; t < nt; t += 2) {
            const bool last = (t == nt - 2);
            const char* a1 = cA + (size_t)(t + 1) * kstep;
            const char* a2 = last ? nA : cA + (size_t)(t + 2) * kstep; const char* b2 = last ? nB : cB + (size_t)(t + 2) * kstep;
            const char* a3 = a2 + kstep; const char* b3 = b2 + kstep;
            if (last && has_next) S.a_ready(nxt);
            if constexpr (SP2) {
            PG8_LDB(B0, 0, 0); PG8_LDB(B1, 0, 1); PG8_SCHED; PG8_LDA(At, 0, 0); PG8_STAGE(PG8_SA(1, 1), a1 + hstepA, voffA);
            PG8_WAIT_V(8); PG8_WAIT_L(0); PG8_BAR; PG8_MMA(0, 0, At, B0); PG8_MMA(0, 1, At, B1); PG8_BAR; PG8_SCHED;
            PG8_LDA(At, 0, 1); PG8_STAGE(PG8_SB(0, 0), b2, voffB); PG8_STAGE(PG8_SB(0, 1), b2 + hstepB, voffB); PG8_STAGE(PG8_SA(0, 0), a2, voffA);
            PG8_WAIT_V(8); PG8_WAIT_L(0); PG8_BAR; PG8_MMA(1, 0, At, B0); PG8_MMA(1, 1, At, B1); PG8_BAR; PG8_SCHED;
            PG8_LDB(B0, 1, 0); PG8_LDB(B1, 1, 1); PG8_SCHED; PG8_LDA(At, 1, 0); PG8_STAGE(PG8_SA(0, 1), a2 + hstepA, voffA);
            PG8_WAIT_V(8); PG8_WAIT_L(0); PG8_BAR; PG8_MMA(0, 0, At, B0); PG8_MMA(0, 1, At, B1); PG8_BAR; PG8_SCHED;
            PG8_LDA(At, 1, 1); PG8_STAGE(PG8_SB(1, 0), b3, voffB); PG8_STAGE(PG8_SB(1, 1), b3 + hstepB, voffB); PG8_STAGE(PG8_SA(1, 0), a3, voffA);
            PG8_WAIT_V(8); PG8_WAIT_L(0); PG8_BAR; PG8_MMA(1, 0, At, B0); PG8_MMA(1, 1, At, B1); PG8_BAR; PG8_SCHED;
            } else {
            PG8_LDB(B0, 0, 0); PG8_SCHED; PG8_LDA(At, 0, 0); PG8_STAGE(PG8_SA(1, 1), a1 + hstepA, voffA);
            PG8_WAIT_L(8); PG8_BAR; PG8_WAIT_L(0); PG8_MMA(0, 0, At, B0); PG8_BAR; PG8_SCHED;
            PG8_LDB(B1, 0, 1); PG8_STAGE(PG8_SB(0, 0), b2, voffB);
            PG8_BAR; PG8_WAIT_L(0); PG8_MMA(0, 1, At, B1); PG8_BAR;
            PG8_LDA(At, 0, 1); PG8_STAGE(PG8_SA(0, 0), a2, voffA);
            PG8_BAR; PG8_WAIT_L(0); PG8_MMA(1, 0, At, B0); PG8_BAR; PG8_SCHED;
            PG8_STAGE(PG8_SB(0, 1), b2 + hstepB, voffB);
            PG8_WAIT_V(6); PG8_BAR; PG8_MMA(1, 1, At, B1); PG8_BAR;
            PG8_LDB(B0, 1, 0); PG8_SCHED; PG8_LDA(At, 1, 0); PG8_STAGE(PG8_SA(0, 1), a2 + hstepA, voffA);
            PG8_WAIT_L(8); PG8_BAR; PG8_WAIT_L(0); PG8_MMA(0, 0, At, B0); PG8_BAR; PG8_SCHED;
            PG8_LDB(B1, 1, 1); PG8_STAGE(PG8_SB(1, 0), b3, voffB);
            PG8_BAR; PG8_WAIT_L(0); PG8_MMA(0, 1, At, B1); PG8_BAR;
            PG8_LDA(At, 1, 1); PG8_STAGE(PG8_SA(1, 0), a3, voffA);
            PG8_BAR; PG8_WAIT_L(0); PG8_MMA(1, 0, At, B0); PG8_BAR; PG8_SCHED;
            PG8_STAGE(PG8_SB(1, 1), b3 + hstepB, voffB);
            PG8_WAIT_V(6); PG8_BAR; PG8_MMA(1, 1, At, B1); PG8_BAR;
            }
        }
        if constexpr (ALIGN_EPI) { if (wr == 0) PG8_BAR; }
        if constexpr (!Epi::AFTER_DRAIN) { E(acc, cur, wr, wc, fr, fq); S.done(cur); }
        if (!has_next) break;
#pragma unroll
        for (int a = 0; a < 2; ++a)
#pragma unroll
            for (int b = 0; b < 2; ++b)
#pragma unroll
                for (int m = 0; m < 4; ++m)
#pragma unroll
                    for (int n = 0; n < 2; ++n) acc[a][b][m][n] = (f32x4){0.f, 0.f, 0.f, 0.f};
        cur = nxt; cA = nA; cB = nB; ++ui;
        if constexpr (ALIGN_EPI) { if (wr == 1) PG8_BAR; }
    }
    PG8_WAIT_V(0);
    if constexpr (!ALIGN_EPI) { if (wr == 0) PG8_BAR; }
    PG8_BAR;
    if constexpr (Epi::AFTER_DRAIN) { E.fused(acc, cur, wr, wc, fr, fq, lds, wid, lane); S.done(cur); }
#undef PG8_SA
#undef PG8_SB
#undef PG8_STAGE
#undef PG8_LDA
#undef PG8_LDB
#undef PG8_MMA
#undef PG8_WAIT_V
#undef PG8_WAIT_L
#undef PG8_BAR
#undef PG8_SCHED
}
}

using pg8::h16; using pg8::h16x8; using pg8::f32x4; using pg8::f32x2; using pg8::u32x4; using pg8::u32x2; using pg8::pk_h2;
#define LAS __attribute__((address_space(3)))
constexpr int NWAVES = 8;
constexpr int D = 1024, BATCH = 8, SEQ = 4096, M = BATCH * SEQ, FF = 2816, NH = 16, HD = 64;
constexpr float LN_EPS = 1e-5f;
constexpr size_t MiB = 1u << 20;
constexpr size_t WS_MOD = 0;
constexpr size_t WS_STATS = 1 * MiB;
constexpr size_t WS_DFT128 = 1 * MiB + 512 * 1024;
constexpr size_t WS_BAR = 1 * MiB + 768 * 1024;
constexpr size_t WS_WQK = 2 * MiB, WS_WV = 6 * MiB, WS_WO = 8 * MiB, WS_FWO = 10 * MiB, WS_WUP0 = 12 * MiB, WS_WUP1 = 23 * MiB, WS_WDN0 = 34 * MiB, WS_WDN1 = 34 * MiB + 5632 * 1024, WS_EDGE = 46 * MiB;
constexpr size_t WS_U = 80 * MiB, WS_ZA = 144 * MiB, WS_BIG = 272 * MiB, WS_END = 464 * MiB;
constexpr size_t WS_QK = WS_BIG, WS_VT = WS_BIG + 128 * MiB, WS_H = WS_BIG, WS_PQT = WS_BIG, WS_F = WS_BIG + 128 * MiB;
static_assert(WS_WDN1 + 5632 * 1024 <= WS_EDGE && WS_EDGE + (size_t)512 * 6 * 2816 * 4 <= WS_U, "ws map");
constexpr int LDS_BYTES = 152 * 1024;
constexpr int ATT_K_OFF = 0, ATT_V_OFF = 73728, ATT_VSTRIDE = 1160, ATT_B_OFF = ATT_V_OFF + 64 * ATT_VSTRIDE;
static_assert(ATT_B_OFF + 2048 <= LDS_BYTES, "lds map");
constexpr int N_PHASES = 18;
#define PROBE_MASK 0
#define PROBE_SYNC 0

struct Args { const float* in[16]; float* out; unsigned char* ws; int ph_lo, ph_hi, coop, pad; };

__device__ __forceinline__ float wave_sum(float v) {
#pragma unroll
    for (int o = 1; o < 64; o <<= 1) v += __shfl_xor(v, o);
    return v;
}
__device__ __forceinline__ int clipi(int v, int lo, int hi) { return v < lo ? lo : (v > hi ? hi : v); }

template <int KIND>
__device__ __forceinline__ void p0_transpose_item(const float* W, int ldw, int col0, int K, int ncols, h16* WT, LAS float* scr, int item, int lane) {
    const int nblk = ncols / 32, kb = item / nblk, nb = item % nblk, k0 = 64 * kb, n0 = 32 * nb;
#pragma unroll 8
    for (int i = 0; i < 32; ++i) { const int kk = 2 * i + (lane >> 5); scr[kk * 33 + (lane & 31)] = W[(size_t)(k0 + kk) * ldw + col0 + n0 + (lane & 31)]; }
    asm volatile("s_waitcnt lgkmcnt(0)" ::: "memory");
    const int c = lane & 7;
#pragma unroll
    for (int j = 0; j < 4; ++j) { const int n = (lane >> 3) + 8 * j; const LAS float* s = scr + (8 * c) * 33 + n;
        u32x4 o; o.x = pk_h2(s[0 * 33], s[1 * 33]); o.y = pk_h2(s[2 * 33], s[3 * 33]); o.z = pk_h2(s[4 * 33], s[5 * 33]); o.w = pk_h2(s[6 * 33], s[7 * 33]);
        int dr = n0 + n;
        if (KIND == 1) { const int f = dr % FF, isg = dr / FF; dr = (f >> 7) * 256 + isg * 128 + (f & 127); }
        *(u32x4*)(WT + (size_t)dr * K + k0 + 8 * c) = o; }
    asm volatile("s_waitcnt lgkmcnt(0)" ::: "memory");
}

template <int MODE, bool PERMROWS = false>
__device__ __forceinline__ void ln_rows(const float* src, const float* gam, const float* bet, const float* modsh, const float* modsc, h16* U, float* stats, float* outf, int G, int wid, int lane) {
    const int gw = blockIdx.x * NWAVES + wid, NGW = G * NWAVES;
    f32x4 gm[4], bt[4];
    if (MODE != 0) {
#pragma unroll
        for (int j = 0; j < 4; ++j) { gm[j] = *((const f32x4*)gam + lane + 64 * j); bt[j] = *((const f32x4*)bet + lane + 64 * j); }
    }
    for (int row = gw; row < M; row += NGW) {
        const int b = row >> 12;
        const f32x4* xr = (const f32x4*)(src + (size_t)row * D) + lane;
        f32x4 v[4];
#pragma unroll
        for (int j = 0; j < 4; ++j) v[j] = xr[64 * j];
        if (MODE != 0) {
            float s = 0.f;
#pragma unroll
            for (int j = 0; j < 4; ++j) s += (v[j].x + v[j].y) + (v[j].z + v[j].w);
            const float mean = wave_sum(s) * (1.f / D); float s2 = 0.f;
#pragma unroll
            for (int j = 0; j < 4; ++j) { v[j] = v[j] - mean; s2 += (v[j].x * v[j].x + v[j].y * v[j].y) + (v[j].z * v[j].z + v[j].w * v[j].w); }
            const float rstd = 1.f / sqrtf(wave_sum(s2) * (1.f / D) + LN_EPS);
            if (MODE == 1 && lane == 0) *(f32x2*)(stats + 2 * row) = (f32x2){mean, rstd};
#pragma unroll
            for (int j = 0; j < 4; ++j) v[j] = v[j] * rstd * gm[j] + bt[j];
        }
        if (MODE == 2) {
            f32x4* o = (f32x4*)(outf + (size_t)row * D) + lane;
#pragma unroll
            for (int j = 0; j < 4; ++j) o[64 * j] = v[j];
        } else {
            const f32x4* sh = (const f32x4*)(modsh + b * 6144) + lane; const f32x4* sc = (const f32x4*)(modsc + b * 6144) + lane;
            const int urow = PERMROWS ? ((row & ~4095) | ((row & 63) << 6) | ((row >> 6) & 63)) : row;
            u32x2* o8 = (u32x2*)(U + (size_t)urow * D) + lane;
#pragma unroll
            for (int j = 0; j < 4; ++j) { const f32x4 t = v[j] * (sc[64 * j] + 1.0f) + sh[64 * j]; u32x2 w; w.x = pk_h2(t.x, t.y); w.y = pk_h2(t.z, t.w); o8[64 * j] = w; }
        }
    }
}

__device__ __forceinline__ void ffn_fixup(const float* edge, const float* cw, const float* cb, h16* H, int G) {
    const int total = 512 * 2 * (FF / 4);
    int tid = threadIdx.x; asm volatile("" : "+v"(tid));
    for (int it = blockIdx.x * 512 + tid; it < total; it += G * 512) {
        const int f4 = it % (FF / 4), rest = it / (FF / 4), which = rest & 1, blk = rest >> 1, f = 4 * f4;
        const float* eb = edge + (size_t)blk * 6 * FF + f;
        f32x4 p, a, q, g; const f32x4 z4 = (f32x4){0.f, 0.f, 0.f, 0.f};
        if (which == 0) { p = ((blk & 63) == 0) ? z4 : *(const f32x4*)(eb - 6 * FF + 3 * FF); a = *(const f32x4*)(eb); q = *(const f32x4*)(eb + FF); g = *(const f32x4*)(eb + 4 * FF); }
        else { p = *(const f32x4*)(eb + 2 * FF); a = *(const f32x4*)(eb + 3 * FF); q = ((blk & 63) == 63) ? z4 : *(const f32x4*)(eb + 6 * FF); g = *(const f32x4*)(eb + 5 * FF); }
        const f32x4 w0 = *(const f32x4*)(cw + f), w1 = *(const f32x4*)(cw + FF + f), w2 = *(const f32x4*)(cw + 2 * FF + f), bb = *(const f32x4*)(cb + f);
        const f32x4 v = bb + w0 * p + w1 * a + w2 * q;
        const int row = blk * 64 + (which ? 63 : 0);
        u32x2 w; w.x = pk_h2(pg8::gelu_tanh(v.x) * g.x, pg8::gelu_tanh(v.y) * g.y); w.y = pk_h2(pg8::gelu_tanh(v.z) * g.z, pg8::gelu_tanh(v.w) * g.w);
        *(u32x2*)(H + (size_t)row * FF + f) = w;
    }
}

__device__ __forceinline__ void attn_stage_row(LAS unsigned char* Kl, LAS unsigned char* Vl, int row, int st_tok, int st_ch, const u32x4& kv, const u32x4& vv) {
    const int slot = row % 9;
    *(LAS u32x4*)(Kl + slot * 8192 + st_tok * 128 + ((st_ch ^ ((st_tok >> 1) & 7)) * 16)) = kv;
    LAS u32x2* p = (LAS u32x2*)(Vl + st_tok * ATT_VSTRIDE + slot * 128 + st_ch * 16); p[0] = (u32x2){vv.x, vv.y}; p[1] = (u32x2){vv.z, vv.w};
}
__device__ __forceinline__ void attn_phase(LAS unsigned char* lds, const h16* QK, const h16* VT, const float* rpb, h16* AO, int G, int tid, int wid, int lane) {
    LAS unsigned char* Kl = lds + ATT_K_OFF; LAS unsigned char* Vl = lds + ATT_V_OFF; LAS float* Bl = (LAS float*)(lds + ATT_B_OFF);
    const int l15 = lane & 15, fq = lane >> 4, qcb = wid & 3, qro = wid >> 2;
    const int cq = qcb * 16 + l15, cs = clipi(cq - 8, 0, 48);
    const int st_tok = tid >> 3, st_ch = tid & 7;
    const float L2E = 1.44269504089f;
    for (int run = blockIdx.x; run < 256; run += G) {
        const int bh = run >> 1, b = bh >> 4, h = bh & 15, rp0 = (run & 1) * 16;
        const h16* kbase = QK + (size_t)(b * SEQ + st_tok) * 2048 + 1024 + h * 64 + st_ch * 8;
        const h16* vbase = VT + (size_t)(h * 64 + st_tok) * M + b * SEQ + st_ch * 8;
        const h16* qbase = QK + (size_t)(b * SEQ + cq) * 2048 + h * 64 + fq * 8;
        __syncthreads();
        if (tid < 465) Bl[tid] = rpb[h * 465 + tid];
        int prev_uhi;
        {   const int r0 = 2 * rp0, ulo = clipi(r0 - 4, 0, 56), uhi = clipi(r0 - 3, 0, 56) + 7;
#pragma unroll 3
            for (int row = ulo; row <= uhi; ++row) { const u32x4 kv = *(const u32x4*)(kbase + (size_t)row * 64 * 2048), vv = *(const u32x4*)(vbase + row * 64); attn_stage_row(Kl, Vl, row, st_tok, st_ch, kv, vv); }
            prev_uhi = uhi; }
        h16x8 nq0 = *(const h16x8*)(qbase + (size_t)(2 * rp0 + qro) * 64 * 2048), nq1 = *(const h16x8*)(qbase + (size_t)(2 * rp0 + qro) * 64 * 2048 + 32);
        u32x4 nk[2], nv[2]; int nrow0 = 0, nnew = 0;
#pragma unroll 1
        for (int sidx = 0; sidx < 16; ++sidx) {
            const int rp = rp0 + sidx, r0 = 2 * rp;
            if (sidx > 0) { __syncthreads();
                if (nnew > 0) attn_stage_row(Kl, Vl, nrow0, st_tok, st_ch, nk[0], nv[0]);
                if (nnew > 1) attn_stage_row(Kl, Vl, nrow0 + 1, st_tok, st_ch, nk[1], nv[1]); }
            __syncthreads();
            const h16x8 q0 = nq0, q1 = nq1;
            if (sidx + 1 < 16) {
                const int n_r0 = r0 + 2, n_uhi = clipi(n_r0 - 3, 0, 56) + 7;
                nrow0 = prev_uhi + 1; nnew = n_uhi - prev_uhi; prev_uhi = n_uhi;
                if (nnew > 0) { nk[0] = *(const u32x4*)(kbase + (size_t)nrow0 * 64 * 2048); nv[0] = *(const u32x4*)(vbase + nrow0 * 64); }
                if (nnew > 1) { nk[1] = *(const u32x4*)(kbase + (size_t)(nrow0 + 1) * 64 * 2048); nv[1] = *(const u32x4*)(vbase + (nrow0 + 1) * 64); }
                nq0 = *(const h16x8*)(qbase + (size_t)(n_r0 + qro) * 64 * 2048); nq1 = *(const h16x8*)(qbase + (size_t)(n_r0 + qro) * 64 * 2048 + 32);
            }
            const int qr = r0 + qro, rs = clipi(qr - 4, 0, 56);
            const int slot0 = rs % 9;
            float mrun = -INFINITY, lsum = 0.f;
            f32x4 o[4];
#pragma unroll
            for (int db = 0; db < 4; ++db) o[db] = (f32x4){0.f, 0.f, 0.f, 0.f};
#pragma unroll
            for (int i2 = 0; i2 < 4; ++i2) {
                int slotv[2];
                f32x4 sc[2][3];
                float mloc = -INFINITY;
#pragma unroll
                for (int e = 0; e < 2; ++e) {
                    const int i = 2 * i2 + e; int sl = slot0 + i; sl = sl >= 9 ? sl - 9 : sl; slotv[e] = sl;
                    const LAS float* brow = Bl + (rs + i - qr + 7) * 31;
#pragma unroll
                    for (int t = 0; t < 3; ++t) {
                        const int kcbr = qcb - 1 + t, kcb = clipi(kcbr, 0, 3); const bool tv = (kcbr == kcb);
                        const int tok = kcb * 16 + l15, sw = (tok >> 1) & 7;
                        const LAS unsigned char* kp = Kl + sl * 8192 + tok * 128;
                        const h16x8 k0 = *(const LAS h16x8*)(kp + ((fq ^ sw) * 16)), k1 = *(const LAS h16x8*)(kp + (((4 + fq) ^ sw) * 16));
                        f32x4 a = (f32x4){0.f, 0.f, 0.f, 0.f};
                        a = __builtin_amdgcn_mfma_f32_16x16x32_f16(k0, q0, a, 0, 0, 0);
                        a = __builtin_amdgcn_mfma_f32_16x16x32_f16(k1, q1, a, 0, 0, 0);
#pragma unroll
                        for (int j = 0; j < 4; ++j) { const int kc = kcb * 16 + 4 * fq + j; const bool ok = tv && (kc >= cs) && (kc < cs + 16); const int dc = clipi(kc - cq + 15, 0, 30);
                            const float bv = brow[dc]; const float v = (a[j] + bv) + (ok ? 0.f : -INFINITY); a[j] = v; mloc = fmaxf(mloc, v); }
                        sc[e][t] = a;
                    }
                }
                mloc = fmaxf(mloc, __shfl_xor(mloc, 16)); mloc = fmaxf(mloc, __shfl_xor(mloc, 32));
                const float mnew = fmaxf(mrun, mloc), alpha = __builtin_amdgcn_exp2f((mrun - mnew) * L2E), mb = mnew * L2E;
                mrun = mnew; lsum *= alpha;
#pragma unroll
                for (int db = 0; db < 4; ++db) o[db] = o[db] * alpha;
#pragma unroll
                for (int t = 0; t < 3; ++t) {
                    const int kcb = clipi(qcb - 1 + t, 0, 3);
                    h16x8 p;
#pragma unroll
                    for (int e = 0; e < 2; ++e)
#pragma unroll
                        for (int j = 0; j < 4; ++j) { const float pe = __builtin_amdgcn_exp2f(sc[e][t][j] * L2E - mb); lsum += pe; p[4 * e + j] = (h16)pe; }
                    const int tofs = (kcb * 16 + 4 * fq) * 2;
#pragma unroll
                    for (int db = 0; db < 4; ++db) {
                        const LAS unsigned char* vp = Vl + (db * 16 + l15) * ATT_VSTRIDE + tofs;
                        const u32x2 lo = *(const LAS u32x2*)(vp + slotv[0] * 128), hi = *(const LAS u32x2*)(vp + slotv[1] * 128);
                        const u32x4 vw = (u32x4){lo.x, lo.y, hi.x, hi.y};
                        o[db] = __builtin_amdgcn_mfma_f32_16x16x32_f16(__builtin_bit_cast(h16x8, vw), p, o[db], 0, 0, 0);
                    }
                }
            }
            lsum += __shfl_xor(lsum, 16); lsum += __shfl_xor(lsum, 32);
            const float inv = 1.0f / lsum;
            h16* op = AO + (size_t)(b * SEQ + qr * 64 + cq) * D + h * 64 + 4 * fq;
#pragma unroll
            for (int db = 0; db < 4; ++db) { const f32x4 v = o[db] * inv; u32x2 w; w.x = pk_h2(v.x, v.y); w.y = pk_h2(v.z, v.w); *(u32x2*)(op + db * 16) = w; }
        }
    }
    __syncthreads();
}

#define XB_TMO      128
#define XB_XCNT(j)  (256  + 64 * (j))
#define XB_XSUB(j)  (1280 + 64 * (j))
#define XB_XGEN(j)  (2304 + 64 * (j))
#define XB_TOP      3328
#define XB_TOPGEN   3392
#define XCD_BAR_WORDS 3456
#define XB_SPIN_CAP (1u << 18)

__device__ __forceinline__ unsigned xb_ld(unsigned* p)              { return __hip_atomic_load(p, __ATOMIC_RELAXED, __HIP_MEMORY_SCOPE_AGENT); }
__device__ __forceinline__ unsigned xb_add(unsigned* p, unsigned v) { return __hip_atomic_fetch_add(p, v, __ATOMIC_RELAXED, __HIP_MEMORY_SCOPE_AGENT); }
__device__ __forceinline__ unsigned xb_xcc_id() { return (unsigned)__builtin_amdgcn_s_getreg((3 << 11) | 20) & 0xFu; }
#define XB_SPIN(cond, bar) do { unsigned _sp = 0; while (cond) { __builtin_amdgcn_s_sleep(1); \
    if ((++_sp & 255u) == 0u) { if (xb_ld(&(bar)[XB_TMO])) break; if (_sp > XB_SPIN_CAP) { atomicAdd(&(bar)[XB_TMO], 1u); break; } } } } while (0)

struct XcdBarrier {
    unsigned* bar; unsigned x;
    volatile LAS unsigned* st;
};

__device__ __forceinline__ XcdBarrier xcd_barrier_post(unsigned* bar, volatile LAS unsigned* st) {
    XcdBarrier b; b.bar = bar; b.x = xb_xcc_id(); b.st = st;
    if (threadIdx.x == 0) (void)xb_add(&bar[XB_XCNT(b.x)], 1u);
    return b;
}
__device__ __forceinline__ void xcd_barrier_complete(unsigned* bar, unsigned x, unsigned& nloc, unsigned& nx) {
    const unsigned G = gridDim.x * gridDim.y * gridDim.z;
    unsigned sum, cnt, mine, sp = 0u;
    for (;;) {
        sum = 0u; cnt = 0u; mine = 0u;
#pragma unroll
        for (unsigned j = 0; j < 16; ++j) { const unsigned c = xb_ld(&bar[XB_XCNT(j)]); sum += c; cnt += (c > 0u) ? 1u : 0u; mine = (j == x) ? c : mine; }
        if (sum == G) break;
        __builtin_amdgcn_s_sleep(1);
        if ((++sp & 255u) == 0u) { if (xb_ld(&bar[XB_TMO])) break; if (sp > XB_SPIN_CAP) { atomicAdd(&bar[XB_TMO], 1u); break; } }
    }
    nloc = mine > 0u ? mine : 1u; nx = cnt > 0u ? cnt : 1u;
}

__device__ __forceinline__ void xcd_barrier(const XcdBarrier& b) {
    asm volatile("s_waitcnt vmcnt(0)" ::: "memory");
    __syncthreads();
    if (threadIdx.x == 0) {
        unsigned* bar = b.bar;
        __builtin_amdgcn_s_waitcnt(0);
        unsigned nloc = b.st[0], nx = b.st[1];
        if (nloc == 0u) { xcd_barrier_complete(bar, b.x, nloc, nx); b.st[0] = nloc; b.st[1] = nx; }
        const unsigned old = xb_add(&bar[XB_XSUB(b.x)], 1u);
        const unsigned gen = old / nloc;
        if (old + 1u == (gen + 1u) * nloc) {
            __builtin_amdgcn_fence(__ATOMIC_RELEASE, "agent");
            asm volatile("s_waitcnt vmcnt(0)" ::: "memory");
            const unsigned og = xb_add(&bar[XB_TOP], 1u);
            const unsigned tg = og / nx;
            if (og + 1u == (tg + 1u) * nx) xb_add(&bar[XB_TOPGEN], 1u);
            else XB_SPIN(xb_ld(&bar[XB_TOPGEN]) == tg, bar);
            __builtin_amdgcn_fence(__ATOMIC_ACQUIRE, "agent");
            xb_add(&bar[XB_XGEN(b.x)], 1u);
            asm volatile("s_waitcnt vmcnt(0)" ::: "memory");
        } else {
            XB_SPIN(xb_ld(&bar[XB_XGEN(b.x)]) == gen, bar);
            __builtin_amdgcn_fence(__ATOMIC_ACQUIRE, "agent");
            asm volatile("s_waitcnt vmcnt(0)" ::: "memory");
        }
    }
    __syncthreads();
}


constexpr int DF_TW_OFF = 0, DF_OM_OFF = 32768, DF_PHI_OFF = 65536, DF_OUT_OFF = 81920, DF_OUT_ROW = 136;
static_assert(DF_OUT_OFF + 8 * 64 * DF_OUT_ROW <= LDS_BYTES, "dft lds map");
__device__ __forceinline__ void dft2d_phase(LAS unsigned char* lds, const h16* PQT, h16* Y, int G, int tid, int wid, int lane) {
    LAS f32x2* TW = (LAS f32x2*)(lds + DF_TW_OFF);
    LAS unsigned char* OmL = lds + DF_OM_OFF;
    LAS unsigned char* Ol = lds + DF_OUT_OFF;
    const int n = lane & 15, kq = lane >> 4;
    for (int i = tid; i < 4096; i += 512) { float sn, cs; sincospif((float)i * (1.0f / 2048.0f), &sn, &cs); TW[i] = (f32x2){cs, sn}; }
    __syncthreads();
    for (int f = wid; f < 32; f += NWAVES) {
        const int nt = f >> 2, ks = f & 3, p = 16 * (nt >> 1) + n, rip = nt & 1, ri = ks >> 1;
        h16x8 v;
#pragma unroll
        for (int e = 0; e < 8; ++e) { const int a = 32 * (ks & 1) + 8 * kq + e; const f32x2 t = TW[((p * a) & 63) * 64];
            const float val = (rip == ri) ? t.x : (rip == 0 ? t.y : -t.y);
            v[e] = (h16)(val * 0.125f); }
        *(LAS h16x8*)(OmL + (f * 64 + lane) * 16) = v;
    }
    LAS unsigned char* PhL = lds + DF_PHI_OFF;
    for (int f = wid; f < 16; f += NWAVES) {
        const int qt = f >> 2, ks2 = f & 3, q = 16 * qt + n;
        h16x8 v;
#pragma unroll
        for (int e = 0; e < 8; ++e) { const int c = 32 * (ks2 & 1) + 16 * (e >> 2) + 4 * kq + (e & 3); const f32x2 t = TW[((q * c) & 63) * 64];
            v[e] = (h16)(((ks2 >> 1) ? t.y : t.x) * 0.125f); }
        *(LAS h16x8*)(PhL + (f * 64 + lane) * 16) = v;
    }
    __syncthreads();
    for (int it = blockIdx.x; it < 1024; it += G) {
        int cb = it;
        if (G == 256) { const int bx = it & 255, i = it >> 8, x = bx & 7, y = bx >> 3; cb = (x * 16 + (y >> 3) * 4 + i) * 8 + (y & 7); }
        const int b = cb >> 7, ch = (cb & 127) * 8 + wid;
        const h16* zp = PQT + (size_t)(b * 1024 + ch) * 8192 + n * 64 + 8 * kq;
        h16x8 zt[4][4];
#pragma unroll
        for (int ct = 0; ct < 4; ++ct)
#pragma unroll
            for (int ks = 0; ks < 4; ++ks) zt[ct][ks] = *(const h16x8*)(zp + (ks >> 1) * 4096 + ct * 1024 + (ks & 1) * 32);
#pragma unroll
        for (int pt = 0; pt < 4; ++pt) {
            f32x4 aR[4], aI[4];
#pragma unroll
            for (int ct = 0; ct < 4; ++ct) { aR[ct] = (f32x4){0.f, 0.f, 0.f, 0.f}; aI[ct] = (f32x4){0.f, 0.f, 0.f, 0.f}; }
#pragma unroll
            for (int ks = 0; ks < 4; ++ks) {
                const h16x8 bR = *(const LAS h16x8*)(OmL + (((2 * pt) * 4 + ks) * 64 + lane) * 16), bI = *(const LAS h16x8*)(OmL + (((2 * pt + 1) * 4 + ks) * 64 + lane) * 16);
#pragma unroll
                for (int ct = 0; ct < 4; ++ct) { aR[ct] = __builtin_amdgcn_mfma_f32_16x16x32_f16(zt[ct][ks], bR, aR[ct], 0, 0, 0); aI[ct] = __builtin_amdgcn_mfma_f32_16x16x32_f16(zt[ct][ks], bI, aI[ct], 0, 0, 0); }
            }
            const int p = 16 * pt + n;
            h16x8 tpR[2], tpI[2];
#pragma unroll
            for (int ct = 0; ct < 4; ++ct)
#pragma unroll
                for (int j = 0; j < 4; ++j) { const int c = 16 * ct + 4 * kq + j; const f32x2 t = TW[(c * p) & 4095];
                    const float tr = aR[ct][j], ti = aI[ct][j];
                    tpR[ct >> 1][4 * (ct & 1) + j] = (h16)(tr * t.x + ti * t.y); tpI[ct >> 1][4 * (ct & 1) + j] = (h16)(ti * t.x - tr * t.y); }
#pragma unroll
            for (int qt = 0; qt < 4; ++qt) {
                f32x4 d = (f32x4){0.f, 0.f, 0.f, 0.f};
                const LAS h16x8* ph = (const LAS h16x8*)(PhL + ((qt * 4) * 64 + lane) * 16);
                d = __builtin_amdgcn_mfma_f32_16x16x32_f16(tpR[0], ph[0], d, 0, 0, 0);
                d = __builtin_amdgcn_mfma_f32_16x16x32_f16(tpR[1], ph[64], d, 0, 0, 0);
                d = __builtin_amdgcn_mfma_f32_16x16x32_f16(tpI[0], ph[128], d, 0, 0, 0);
                d = __builtin_amdgcn_mfma_f32_16x16x32_f16(tpI[1], ph[192], d, 0, 0, 0);
                u32x2 w; w.x = pk_h2(d[0], d[1]); w.y = pk_h2(d[2], d[3]);
                *(LAS u32x2*)(Ol + (wid * 64 + 16 * qt + n) * DF_OUT_ROW + (16 * pt + 4 * kq) * 2) = w;
            }
            asm volatile("" ::: "memory");
        }
        __syncthreads();
        {
            h16* yb = Y + (size_t)(b * SEQ) * D + (cb & 127) * 8;
#pragma unroll
            for (int r = 0; r < 8; ++r) {
                const int k = tid + 512 * r, q = k >> 6, p = k & 63;
                unsigned short hv[8];
#pragma unroll
                for (int w = 0; w < 8; ++w) hv[w] = *(const LAS unsigned short*)(Ol + (w * 64 + q) * DF_OUT_ROW + p * 2);
                u32x4 o; o.x = hv[0] | ((unsigned)hv[1] << 16); o.y = hv[2] | ((unsigned)hv[3] << 16); o.z = hv[4] | ((unsigned)hv[5] << 16); o.w = hv[6] | ((unsigned)hv[7] << 16);
                *(u32x4*)(yb + (size_t)k * D) = o;
            }
        }
        __syncthreads();
    }
}

__global__ void __launch_bounds__(NWAVES * 64, 2) mega_fwd(Args args) {
    extern __shared__ __attribute__((aligned(16))) unsigned char lds_raw[];
    LAS unsigned char* lds = (LAS unsigned char*)lds_raw;
    cg::grid_group grid = cg::this_grid();
    const int G = gridDim.x;
#define PHASE_IDS int tid = threadIdx.x; asm volatile("" : "+v"(tid)); const int lane = tid & 63, wid = __builtin_amdgcn_readfirstlane(tid >> 6); (void)lane; (void)wid;
    unsigned char* ws = args.ws;
    const float* x = args.in[0]; const float* cvec = args.in[1]; const float* ada_w = args.in[2]; const float* ada_b = args.in[3];
    const float* w_qkv = args.in[4]; const float* rpb = args.in[5]; const float* na_wo = args.in[6]; const float* fn_wo = args.in[7];
    const float* ln1_g = args.in[8]; const float* ln1_b = args.in[9]; const float* w_up = args.in[10]; const float* conv_w = args.in[11];
    const float* conv_b = args.in[12]; const float* w_down = args.in[13]; const float* ln2_g = args.in[14]; const float* ln2_b = args.in[15];
    float* out = args.out;
    float* mod = (float*)(ws + WS_MOD); float* stats = (float*)(ws + WS_STATS);
    h16* DFT128 = (h16*)(ws + WS_DFT128);
    h16* Wqk_t = (h16*)(ws + WS_WQK); h16* Wv_t = (h16*)(ws + WS_WV); h16* Wo_t = (h16*)(ws + WS_WO); h16* Fwo_t = (h16*)(ws + WS_FWO);
    h16* Wup0 = (h16*)(ws + WS_WUP0); h16* Wup1 = (h16*)(ws + WS_WUP1); h16* Wdn0 = (h16*)(ws + WS_WDN0); h16* Wdn1 = (h16*)(ws + WS_WDN1);
    float* edge = (float*)(ws + WS_EDGE);
    h16* U = (h16*)(ws + WS_U); float* ZA = (float*)(ws + WS_ZA);
    h16* QKb = (h16*)(ws + WS_QK); h16* VTb = (h16*)(ws + WS_VT); h16* Hb = (h16*)(ws + WS_H); h16* PQT = (h16*)(ws + WS_PQT);

    const int lo = args.ph_lo, hi = args.ph_hi;
    unsigned* barw = (unsigned*)(ws + WS_BAR);
    volatile LAS unsigned* bst = (volatile LAS unsigned*)(lds + LDS_BYTES - 16);
    if (args.coop) {
        if (blockIdx.x == 0) for (int i = threadIdx.x; i < XCD_BAR_WORDS; i += NWAVES * 64) barw[i] = 0u;
        if (threadIdx.x < 2) bst[threadIdx.x] = 0u;
        __syncthreads();
    }
    XcdBarrier xbar; xbar.bar = barw; xbar.x = 0; xbar.st = bst;
#define IN(k) (lo <= (k) && (k) < hi)
#define SEAM(k) do { if (IN(k) && IN((k) + 1)) { xcd_barrier(xbar); if (PROBE_SYNC) xcd_barrier(xbar); } } while (0)
#define REPS(k) _Pragma("unroll 1") for (int rep_ = 0; rep_ < ((PROBE_MASK >> (k)) & 1) + 1; ++rep_)
    const size_t T1K = (size_t)256 * 1024 * 2;

    if (IN(0)) REPS(0) { PHASE_IDS
        LAS float* scr = (LAS float*)(lds + wid * 8448);
        const int gw = blockIdx.x * NWAVES + wid, NGW = G * NWAVES;
        constexpr int I_QK = 16 * 64, I_V = 16 * 32, I_O = 16 * 32, I_UP = 16 * 176, I_DN = 44 * 32;
        constexpr int NITEMS = I_QK + I_V + 2 * I_O + 2 * I_UP + 2 * I_DN;
        for (int it = gw; it < NITEMS; it += NGW) {
            int r = it;
            if (r < I_QK) { p0_transpose_item<0>(w_qkv, 3072, 0, 1024, 2048, Wqk_t, scr, r, lane); continue; } r -= I_QK;
            if (r < I_V) { p0_transpose_item<0>(w_qkv, 3072, 2048, 1024, 1024, Wv_t, scr, r, lane); continue; } r -= I_V;
            if (r < I_O) { p0_transpose_item<0>(na_wo, 1024, 0, 1024, 1024, Wo_t, scr, r, lane); continue; } r -= I_O;
            if (r < I_O) { p0_transpose_item<0>(fn_wo, 1024, 0, 1024, 1024, Fwo_t, scr, r, lane); continue; } r -= I_O;
            if (r < I_UP) { p0_transpose_item<1>(w_up, 5632, 0, 1024, 5632, Wup0, scr, r, lane); continue; } r -= I_UP;
            if (r < I_UP) { p0_transpose_item<1>(w_up + (size_t)1024 * 5632, 5632, 0, 1024, 5632, Wup1, scr, r, lane); continue; } r -= I_UP;
            if (r < I_DN) { p0_transpose_item<0>(w_down, 1024, 0, 2816, 1024, Wdn0, scr, r, lane); continue; } r -= I_DN;
            p0_transpose_item<0>(w_down + (size_t)2816 * 1024, 1024, 0, 2816, 1024, Wdn1, scr, r, lane);
        }
        for (int e = blockIdx.x * 512 + tid; e < 256 * 128; e += G * 512) {
            const int row = e >> 7, c = e & 127, ri = row >> 7, m = row & 127; const float ph = (float)((m * c) & 127) * (1.0f / 128.0f);
            const float v = (ri ? -__builtin_amdgcn_sinf(ph) : __builtin_amdgcn_cosf(ph)) * 0.08838834764831845f;
            DFT128[e] = (h16)v;
        }
        __syncthreads();
        LAS float* cs = (LAS float*)(lds + 80 * 1024);
        LAS float* red = (LAS float*)(lds + 112 * 1024);
        if (blockIdx.x < 192) {
            for (int i = tid; i < 8 * 1024; i += 512) { const float v = cvec[i]; cs[i] = v / (1.0f + __expf(-v)); }
            __syncthreads();
            for (int it = blockIdx.x; it < 192; it += G) {
                const int li = it / 96, e0 = (it % 96) * 64;
                const float* wp = ada_w + (size_t)li * 1024 * 6144 + (size_t)(wid * 128) * 6144 + e0 + lane;
                float a[8];
#pragma unroll
                for (int b = 0; b < 8; ++b) a[b] = 0.f;
#pragma unroll 8
                for (int d = 0; d < 128; ++d) { const float w = wp[(size_t)d * 6144];
#pragma unroll
                    for (int b = 0; b < 8; ++b) a[b] += w * cs[b * 1024 + wid * 128 + d]; }
#pragma unroll
                for (int b = 0; b < 8; ++b) red[(wid * 8 + b) * 64 + lane] = a[b];
                __syncthreads();
                { const int b = tid >> 6, col = tid & 63; float s = ada_b[li * 6144 + e0 + col];
#pragma unroll
                  for (int w = 0; w < 8; ++w) s += red[(w * 8 + b) * 64 + col];
                  mod[(size_t)(li * 8 + b) * 6144 + e0 + col] = s; }
                __syncthreads();
            }
        }
    }
    if (IN(0) && IN(1)) { grid.sync(); xbar = xcd_barrier_post(barw, bst); }
    const float* mod0 = mod; const float* mod1 = mod + 8 * 6144;

    if (IN(1)) REPS(1) { PHASE_IDS ln_rows<0>(x, nullptr, nullptr, mod0 + 0 * 1024, mod0 + 1 * 1024, U, nullptr, nullptr, G, wid, lane); }
    SEAM(1);
    if (IN(2)) REPS(2) {
        { pg8::Gemm g{U, Wqk_t, 1024, 1024, 1024, T1K, T1K, 0}; pg8::StaticOrder S; S.init(M, 2048, G, (int)blockIdx.x);
          pg8::EpiH16 E{QKb, 2048, 0, 0, 1024, 0.125f};
          pg8::gemm_phase<pg8::EpiH16, pg8::StaticOrder, true, true>(lds, g, S, E); }
        { pg8::Gemm g{Wv_t, U, 1024, 1024, 1024, T1K, T1K, 0}; pg8::StaticOrder S; S.init(1024, M, G, (int)blockIdx.x);
          pg8::EpiH16 E{VTb, M, 0, 0, 0, 1.f};
          pg8::gemm_phase<pg8::EpiH16, pg8::StaticOrder, true, true>(lds, g, S, E); }
    }
    SEAM(2);
    if (IN(3)) REPS(3) { PHASE_IDS attn_phase(lds, QKb, VTb, rpb, U, G, tid, wid, lane); }
    SEAM(3);
    if (IN(4)) REPS(4) { pg8::Gemm g{U, Wo_t, 1024, 1024, 1024, T1K, T1K, 0}; pg8::StaticOrder S; S.init(M, 1024, G, (int)blockIdx.x);
        pg8::EpiRes E{x, nullptr, nullptr, nullptr, mod0 + 2 * 1024, ZA};
        pg8::gemm_phase<pg8::EpiRes, pg8::StaticOrder, true, true>(lds, g, S, E); }
    SEAM(4);
#pragma unroll
    for (int L = 0; L < 2; ++L) {
        const int pb = (L == 0) ? 5 : 13;
        const float* modL = L ? mod1 : mod0;
        if (IN(pb)) REPS(pb) { PHASE_IDS ln_rows<1>(ZA, ln1_g + L * 1024, ln1_b + L * 1024, modL + 3 * 1024, modL + 4 * 1024, U, stats, nullptr, G, wid, lane); }
        SEAM(pb);
        if (IN(pb + 1)) REPS(pb + 1) { pg8::Gemm g{U, L ? Wup1 : Wup0, 1024, 1024, 1024, T1K, T1K, 0}; pg8::StaticOrder S; S.init(M, 2 * FF, G, (int)blockIdx.x);
            pg8::EpiUp E{conv_w + (size_t)L * 3 * FF, conv_b + L * FF, Hb, edge};
            pg8::gemm_phase<pg8::EpiUp, pg8::StaticOrder, true, true>(lds, g, S, E); }
        SEAM(pb + 1);
        if (IN(pb + 2)) REPS(pb + 2) ffn_fixup(edge, conv_w + (size_t)L * 3 * FF, conv_b + L * FF, Hb, G);
        SEAM(pb + 2);
        if (IN(pb + 3)) REPS(pb + 3) { pg8::Gemm g{Hb, L ? Wdn1 : Wdn0, FF, FF, FF, (size_t)256 * FF * 2, (size_t)256 * FF * 2, 0}; pg8::StaticOrder S; S.init(M, 1024, G, (int)blockIdx.x);
            pg8::EpiRes E{ZA, stats, ln1_g + L * 1024, ln1_b + L * 1024, modL + 5 * 1024, out};
            pg8::gemm_phase<pg8::EpiRes, pg8::StaticOrder, true, true>(lds, g, S, E); }
        SEAM(pb + 3);
        if (L == 0) {
            if (IN(9)) REPS(9) { PHASE_IDS
                ln_rows<1, true>(out, ln2_g, ln2_b, mod1 + 0 * 1024, mod1 + 1 * 1024, U, stats, nullptr, G, wid, lane);
            }
            SEAM(9);
            if (IN(10)) REPS(10) { int k128 = 128; asm volatile("" : "+s"(k128)); pg8::Gemm g{DFT128, U, 128, 1024, k128, 0, T1K, 256}; pg8::StaticOrder S; S.init(8 * 256, M, G, (int)blockIdx.x);
                pg8::EpiF1 E{PQT};
                pg8::gemm_phase<pg8::EpiF1, pg8::StaticOrder, true, true>(lds, g, S, E); }
            SEAM(10);
            if (IN(11)) REPS(11) { PHASE_IDS dft2d_phase(lds, PQT, U, G, tid, wid, lane); }
            SEAM(11);
            if (IN(12)) REPS(12) { pg8::Gemm g{U, Fwo_t, 1024, 1024, 1024, T1K, T1K, 0}; pg8::StaticOrder S; S.init(M, 1024, G, (int)blockIdx.x);
                pg8::EpiRes E{out, stats, ln2_g, ln2_b, mod1 + 2 * 1024, ZA};
                pg8::gemm_phase<pg8::EpiRes, pg8::StaticOrder, true, true>(lds, g, S, E); }
            SEAM(12);
        }
    }
    if (IN(17)) REPS(17) { PHASE_IDS ln_rows<2>(out, ln2_g + 1024, ln2_b + 1024, nullptr, nullptr, nullptr, nullptr, out, G, wid, lane); }
#undef IN
#undef SEAM
}

extern "C" void kernel_launch(void* const* d_in, const int* in_sizes, int n_in, void* d_out, int out_size, void* d_ws, size_t ws_size, hipStream_t stream) {
    static int grid = 0;
    if (grid == 0) {
        if (n_in != 16 || out_size != M * D || ws_size < WS_END) { fprintf(stderr, "kernel_launch: unexpected shapes (n_in %d out %d ws %zu)\n", n_in, out_size, ws_size); grid = -1; return; }
        int dev = 0, cus = 0, per_cu = 0;
        hipGetDevice(&dev); hipDeviceGetAttribute(&cus, hipDeviceAttributeMultiprocessorCount, dev);
        if (hipFuncSetAttribute((const void*)mega_fwd, hipFuncAttributeMaxDynamicSharedMemorySize, LDS_BYTES) != hipSuccess) { fprintf(stderr, "kernel_launch: hipFuncSetAttribute failed\n"); grid = -1; return; }
        if (hipOccupancyMaxActiveBlocksPerMultiprocessor(&per_cu, (const void*)mega_fwd, NWAVES * 64, LDS_BYTES) != hipSuccess || per_cu < 1) { fprintf(stderr, "kernel_launch: occupancy query says %d\n", per_cu); per_cu = 1; }
        (void)hipGetLastError();
        grid = cus;
        fprintf(stderr, "kernel_launch: grid %d (cus %d, per_cu %d)\n", grid, cus, per_cu);
    }
    if (grid < 0) return;
    Args a{};
    for (int i = 0; i < 16; ++i) a.in[i] = (const float*)d_in[i];
    a.out = (float*)d_out; a.ws = (unsigned char*)d_ws;
#if MK_ONE_LAUNCH
    a.ph_lo = 0; a.ph_hi = N_PHASES; a.coop = 1;
    void* kargs[] = {&a};
    hipError_t e = hipLaunchCooperativeKernel((const void*)mega_fwd, dim3(grid), dim3(NWAVES * 64), kargs, LDS_BYTES, stream);
    if (e != hipSuccess) fprintf(stderr, "cooperative launch failed: %s (grid %d)\n", hipGetErrorString(e), grid);
#else
    for (int p = 0; p < N_PHASES; ++p) { a.ph_lo = p; a.ph_hi = p + 1; a.coop = 0;
        hipLaunchKernelGGL(mega_fwd, dim3(grid), dim3(NWAVES * 64), LDS_BYTES, stream, a); }
#endif
}
```

```cpp
#include <hip/hip_runtime.h>
#include <hip/hip_cooperative_groups.h>
#include <cstdio>
#include <cstdint>
namespace cg = cooperative_groups;

#ifndef MK_ONE_LAUNCH
#define MK_ONE_LAUNCH 1
#endif

namespace pg8 {
#define PG8_LAS __attribute__((address_space(3)))
typedef _Float16 h16;
typedef _Float16 h16x8 __attribute__((ext_vector_type(8)));
typedef _Float16 h16x2 __attribute__((ext_vector_type(2)));
typedef float f32x4 __attribute__((ext_vector_type(4)));
typedef float f32x2 __attribute__((ext_vector_type(2)));
typedef unsigned u32x4 __attribute__((ext_vector_type(4)));
typedef unsigned u32x2 __attribute__((ext_vector_type(2)));
constexpr int BM = 256, BK = 64, HALF = 128, HTB = HALF * BK * 2  , STAGE_BYTES = 8 * HTB, NXCD = 8, WGM = 8;

__host__ __device__ __forceinline__ int lds_byte(int r, int c) { const int st = (r >> 4) * 2 + (c >> 5), rr = r & 15, cc = c & 31, ob = rr * 64 + cc * 2; return st * 1024 + (ob ^ (((ob >> 9) & 1) << 5)); }
__host__ __device__ __forceinline__ void stage_rc(int b, int& R, int& C) { const int st = b / 1024, sb = b % 1024, swz = sb ^ (((sb >> 9) & 1) << 5); R = (st >> 1) * 16 + swz / 64; C = (st & 1) * 32 + (swz % 64) / 2; }
__host__ __device__ __forceinline__ int perm32(int rho) { const int n = rho >> 4, i = rho & 15; return 8 * (i >> 2) + 4 * n + (i & 3); }

struct Unit { int pm, pn; };
struct Gemm { const h16* A; const h16* Bt; int lda, ldb, K; size_t a_tile, b_tile, b_pm_koff; };

struct StaticOrder {
    int nM, nN, nwg, G, c;
    __host__ __device__ void init(int M, int N, int G_, int c_) { nM = M / BM; nN = N / BM; nwg = nM * nN; G = G_; c = c_; }
    __host__ __device__ bool next(int i, Unit& u) const {
        const long L = (long)i * G + c; if (L >= nwg) return false;
        int wgid = (int)L; { const int q = nwg / NXCD, r = nwg % NXCD, xcd = wgid % NXCD, off = wgid / NXCD; wgid = (xcd < r ? xcd * (q + 1) : r * (q + 1) + (xcd - r) * q) + off; }
        const int nig = WGM * nN, gid = wgid / nig, fm = gid * WGM, gsz = (nM - fm) < WGM ? (nM - fm) : WGM;
        u.pm = fm + ((wgid % nig) % gsz); u.pn = (wgid % nig) / gsz; return true;
    }
    __device__ __forceinline__ void a_ready(const Unit&) const {}
    __device__ __forceinline__ void done(const Unit&) const {}
};

__device__ __forceinline__ unsigned pk_h2(float lo, float hi) { h16x2 v; v.x = (h16)lo; v.y = (h16)hi; return __builtin_bit_cast(unsigned, v); }


struct EpiH16 {
    static constexpr bool PERM = true, AFTER_DRAIN = false;
    h16* O; int ldc; int split_cols; size_t split_stride; int scale_cols; float scale;
    __device__ __forceinline__ void operator()(const f32x4 (&acc)[2][2][4][2], const Unit& u, int wr, int wc, int fr, int fq) const {
        const int row0 = u.pm * BM + wr * 64 + fr; int colt = u.pn * BM; h16* base = O;
        const float sc = (colt < scale_cols) ? scale : 1.f;
        if (split_cols) { const int t = colt / split_cols; base += (size_t)t * split_stride; colt -= t * split_cols; }
        const int col0 = colt + wc * 32 + 8 * fq;
#pragma unroll
        for (int ai = 0; ai < 2; ++ai)
#pragma unroll
            for (int m = 0; m < 4; ++m) { h16* rowp = base + (size_t)(row0 + ai * HALF + m * 16) * ldc + col0;
#pragma unroll
                for (int bj = 0; bj < 2; ++bj) { const f32x4 v0 = acc[ai][bj][m][0] * sc, v1 = acc[ai][bj][m][1] * sc;
                    u32x4 w; w.x = pk_h2(v0[0], v0[1]); w.y = pk_h2(v0[2], v0[3]); w.z = pk_h2(v1[0], v1[1]); w.w = pk_h2(v1[2], v1[3]);
                    *(u32x4*)(rowp + bj * HALF) = w; } }
    }
};

struct EpiF1 {
    static constexpr bool PERM = true, AFTER_DRAIN = false;
    h16* PQT;
    __device__ __forceinline__ void operator()(const f32x4 (&acc)[2][2][4][2], const Unit& u, int wr, int wc, int fr, int fq) const {
        const int b = u.pn >> 4, s0 = (u.pn & 15) * 256 + wc * 32 + 8 * fq;
#pragma unroll
        for (int ai = 0; ai < 2; ++ai)
#pragma unroll
            for (int m = 0; m < 4; ++m) { h16* rowp = PQT + (size_t)(b * 1024 + u.pm * 128 + wr * 64 + m * 16 + fr) * 8192 + ai * 4096 + s0;
#pragma unroll
                for (int bj = 0; bj < 2; ++bj) { const f32x4 v0 = acc[ai][bj][m][0], v1 = acc[ai][bj][m][1];
                    u32x4 w; w.x = pk_h2(v0[0], v0[1]); w.y = pk_h2(v0[2], v0[3]); w.z = pk_h2(v1[0], v1[1]); w.w = pk_h2(v1[2], v1[3]);
                    *(u32x4*)(rowp + bj * HALF) = w; } }
    }
};

struct EpiRes {
    static constexpr bool PERM = true, AFTER_DRAIN = false;
    const float* resx; const h16* resz; const float* stats; const float* gam; const float* bet; const float* gate; h16* out;
    __device__ __forceinline__ void operator()(const f32x4 (&acc)[2][2][4][2], const Unit& u, int wr, int wc, int fr, int fq) const {
        const int b = u.pm >> 4; const float ALPHA = 1.41421356237f;
#pragma unroll
        for (int bj = 0; bj < 2; ++bj) {
            const int col = u.pn * BM + bj * HALF + wc * 32 + 8 * fq;
            f32x4 gt[2], gm[2], bt[2];
#pragma unroll
            for (int n = 0; n < 2; ++n) { gt[n] = *(const f32x4*)(gate + b * 6144 + col + 4 * n) + 1.0f;
                if (resz) { gm[n] = *(const f32x4*)(gam + col + 4 * n); bt[n] = *(const f32x4*)(bet + col + 4 * n); } else { gm[n] = (f32x4){1.f, 1.f, 1.f, 1.f}; bt[n] = (f32x4){0.f, 0.f, 0.f, 0.f}; } }
#pragma unroll
            for (int ai = 0; ai < 2; ++ai)
#pragma unroll
                for (int m = 0; m < 4; ++m) {
                    const int row = u.pm * BM + ai * HALF + wr * 64 + m * 16 + fr;
                    f32x4 r0, r1;
                    if (resz) { const h16x8 z = *(const h16x8*)(resz + (size_t)row * 1024 + col); const f32x2 st = *(const f32x2*)(stats + 2 * row);
                        r0 = (f32x4){(float)z[0], (float)z[1], (float)z[2], (float)z[3]}; r1 = (f32x4){(float)z[4], (float)z[5], (float)z[6], (float)z[7]};
                        r0 = (r0 - st.x) * st.y * gm[0] + bt[0]; r1 = (r1 - st.x) * st.y * gm[1] + bt[1]; }
                    else { r0 = *(const f32x4*)(resx + (size_t)row * 1024 + col); r1 = *(const f32x4*)(resx + (size_t)row * 1024 + col + 4); }
                    const f32x4 o0 = r0 * ALPHA + gt[0] * acc[ai][bj][m][0], o1 = r1 * ALPHA + gt[1] * acc[ai][bj][m][1];
                    u32x4 w; w.x = pk_h2(o0[0], o0[1]); w.y = pk_h2(o0[2], o0[3]); w.z = pk_h2(o1[0], o1[1]); w.w = pk_h2(o1[2], o1[3]);
                    *(u32x4*)(out + (size_t)row * 1024 + col) = w;
                }
        }
    }
};

__device__ __forceinline__ float dpp_prev(float old, float src) {
    return __builtin_bit_cast(float, __builtin_amdgcn_update_dpp(__builtin_bit_cast(int, old), __builtin_bit_cast(int, src), 0x111, 0xf, 0xf, false)); }
__device__ __forceinline__ float dpp_next(float old, float src) {
    return __builtin_bit_cast(float, __builtin_amdgcn_update_dpp(__builtin_bit_cast(int, old), __builtin_bit_cast(int, src), 0x101, 0xf, 0xf, false)); }
__device__ __forceinline__ float dpp_ror1(float src) {
    return __builtin_bit_cast(float, __builtin_amdgcn_update_dpp(0, __builtin_bit_cast(int, src), 0x121, 0xf, 0xf, false)); }
__device__ __forceinline__ float dpp_ror15(float src) {
    return __builtin_bit_cast(float, __builtin_amdgcn_update_dpp(0, __builtin_bit_cast(int, src), 0x12f, 0xf, 0xf, false)); }
__device__ __forceinline__ float gelu_tanh(float v) {
    const float y = v + 0.044715f * v * v * v;
    const float e = __builtin_amdgcn_exp2f(-2.302208198f * y);
    return v * __builtin_amdgcn_rcpf(1.0f + e);
}

struct EpiUp {
    static constexpr bool PERM = true, AFTER_DRAIN = false;
    const float* cw; const float* cb; h16* H; float* edge;
    __device__ __forceinline__ void operator()(const f32x4 (&acc)[2][2][4][2], const Unit& u, int wr, int wc, int fr, int fq) const {
        const int f0 = u.pn * 128 + wc * 32 + 8 * fq;
        f32x4 w0[2], w1[2], w2[2], bb[2];
#pragma unroll
        for (int n = 0; n < 2; ++n) { w0[n] = *(const f32x4*)(cw + f0 + 4 * n); w1[n] = *(const f32x4*)(cw + 2816 + f0 + 4 * n); w2[n] = *(const f32x4*)(cw + 2 * 2816 + f0 + 4 * n); bb[n] = *(const f32x4*)(cb + f0 + 4 * n); }
#pragma unroll
        for (int ai = 0; ai < 2; ++ai) {
            const int blk = u.pm * 4 + ai * 2 + wr;
            float* eb = edge + (size_t)blk * 6 * 2816 + f0;
#pragma unroll
            for (int m = 0; m < 4; ++m) {
                unsigned pk[4];
#pragma unroll
                for (int n = 0; n < 2; ++n) {
                    const f32x4 a = acc[ai][0][m][n], g = acc[ai][1][m][n];
                    f32x4 hv;
#pragma unroll
                    for (int j = 0; j < 4; ++j) {
                        const float po = (m > 0) ? dpp_ror1(acc[ai][0][m > 0 ? m - 1 : 0][n][j]) : 0.f;
                        const float no = (m < 3) ? dpp_ror15(acc[ai][0][m < 3 ? m + 1 : 3][n][j]) : 0.f;
                        const float p = dpp_prev(po, a[j]), q = dpp_next(no, a[j]);
                        const float v = bb[n][j] + w0[n][j] * p + w1[n][j] * a[j] + w2[n][j] * q;
                        hv[j] = gelu_tanh(v) * g[j];
                    }
                    pk[2 * n] = pk_h2(hv[0], hv[1]); pk[2 * n + 1] = pk_h2(hv[2], hv[3]);
                    if (m == 0) { if (fr == 0) { *(f32x4*)(eb + 0 * 2816 + 4 * n) = a; *(f32x4*)(eb + 4 * 2816 + 4 * n) = g; } if (fr == 1) *(f32x4*)(eb + 1 * 2816 + 4 * n) = a; }
                    if (m == 3) { if (fr == 14) *(f32x4*)(eb + 2 * 2816 + 4 * n) = a; if (fr == 15) { *(f32x4*)(eb + 3 * 2816 + 4 * n) = a; *(f32x4*)(eb + 5 * 2816 + 4 * n) = g; } }
                }
                const int row = u.pm * BM + ai * HALF + wr * 64 + m * 16 + fr;
                u32x4 w; w.x = pk[0]; w.y = pk[1]; w.z = pk[2]; w.w = pk[3];
                *(u32x4*)(H + (size_t)row * 2816 + f0) = w;
            }
        }
    }
};

template <class Epi, class Sched, bool ALIGN_EPI = false, bool SP2 = false>
__device__ __forceinline__ void gemm_phase(PG8_LAS unsigned char* lds, const Gemm g, const Sched& S, const Epi& E) {
    int tid_ = threadIdx.x; asm volatile("" : "+v"(tid_));
    const int tid = tid_, wid = __builtin_amdgcn_readfirstlane(tid >> 6), lane = tid & 63, wr = wid >> 2, wc = wid & 3, fr = lane & 15, fq = lane >> 4;
    const int K = g.K, nt = K / BK;
    unsigned voffA[2], voffB[2];
#pragma unroll
    for (int i = 0; i < 2; ++i) { int R, C; stage_rc(tid * 16 + i * 8192, R, C); const int Rb = Epi::PERM ? ((R & ~31) + perm32(R & 31)) : R;
        voffA[i] = (unsigned)(R * g.lda + C) * 2u; voffB[i] = (unsigned)(Rb * g.ldb + C) * 2u; }
    const size_t kstep = (size_t)(BK * 2);
    const size_t hstepA = (size_t)HALF * g.lda * 2, hstepB = (size_t)HALF * g.ldb * 2;
    const unsigned ldsw = (unsigned)wid * 1024u;
    const int aoff = lds_byte(wr * 64 + fr, fq * 8), boff = lds_byte(wc * 32 + fr, fq * 8);
#define PG8_SA(b, h) (((b) * 2 + (h)) * HTB)
#define PG8_SB(b, h) ((4 + (b) * 2 + (h)) * HTB)
#define PG8_STAGE(bufoff, gbase, voff) do { _Pragma("unroll") for (int _i = 0; _i < 2; ++_i) \
        __builtin_amdgcn_global_load_lds((const unsigned*)((const char*)(gbase) + (voff)[_i]), (PG8_LAS unsigned*)(lds + (bufoff) + ldsw + _i * 8192), 16, 0, 0); } while (0)
#define PG8_LDA(dst, b, h) do { _Pragma("unroll") for (int m = 0; m < 4; ++m) _Pragma("unroll") for (int k = 0; k < 2; ++k) dst[m][k] = *(const PG8_LAS h16x8*)(lds + PG8_SA(b, h) + aoff + m * 2048 + k * 1024); } while (0)
#define PG8_LDB(dst, b, h) do { _Pragma("unroll") for (int n = 0; n < 2; ++n) _Pragma("unroll") for (int k = 0; k < 2; ++k) dst[n][k] = *(const PG8_LAS h16x8*)(lds + PG8_SB(b, h) + boff + n * 2048 + k * 1024); } while (0)
#define PG8_MMA(ai, bj, At, Bt) do { __builtin_amdgcn_s_setprio(1); _Pragma("unroll") for (int m = 0; m < 4; ++m) _Pragma("unroll") for (int n = 0; n < 2; ++n) _Pragma("unroll") for (int k = 0; k < 2; ++k) \
        acc[ai][bj][m][n] = __builtin_amdgcn_mfma_f32_16x16x32_f16(Bt[n][k], At[m][k], acc[ai][bj][m][n], 0, 0, 0); __builtin_amdgcn_s_setprio(0); } while (0)
#define PG8_WAIT_V(n) asm volatile("s_waitcnt vmcnt(" #n ")" ::: "memory")
#define PG8_WAIT_L(n) asm volatile("s_waitcnt lgkmcnt(" #n ")" ::: "memory")
#define PG8_BAR __builtin_amdgcn_s_barrier()
#define PG8_SCHED __builtin_amdgcn_sched_barrier(0)
    Unit cur, nxt; int ui = 0;
    if (!S.next(0, cur)) return;
    f32x4 acc[2][2][4][2];
#pragma unroll
    for (int a = 0; a < 2; ++a)
#pragma unroll
        for (int b = 0; b < 2; ++b)
#pragma unroll
            for (int m = 0; m < 4; ++m)
#pragma unroll
                for (int n = 0; n < 2; ++n) acc[a][b][m][n] = (f32x4){0.f, 0.f, 0.f, 0.f};
    h16x8 At[4][2], B0[2][2], B1[2][2];
    const char* cA = (const char*)g.A + (size_t)cur.pm * g.a_tile; const char* cB = (const char*)g.Bt + (size_t)cur.pn * g.b_tile + (size_t)cur.pm * g.b_pm_koff;
    S.a_ready(cur);
    if constexpr (SP2) {
        PG8_STAGE(PG8_SB(0, 0), cB, voffB); PG8_STAGE(PG8_SB(0, 1), cB + hstepB, voffB); PG8_STAGE(PG8_SA(0, 0), cA, voffA); PG8_STAGE(PG8_SA(0, 1), cA + hstepA, voffA);
        if (wr == 1) PG8_BAR;
        PG8_WAIT_V(2); PG8_BAR;
        PG8_STAGE(PG8_SB(1, 0), cB + kstep, voffB); PG8_STAGE(PG8_SA(1, 0), cA + kstep, voffA); PG8_STAGE(PG8_SB(1, 1), cB + hstepB + kstep, voffB);
        PG8_WAIT_V(6); PG8_BAR;
    } else {
        PG8_STAGE(PG8_SB(0, 0), cB, voffB); PG8_STAGE(PG8_SA(0, 0), cA, voffA); PG8_STAGE(PG8_SB(0, 1), cB + hstepB, voffB); PG8_STAGE(PG8_SA(0, 1), cA + hstepA, voffA);
        if (wr == 1) PG8_BAR;
        PG8_WAIT_V(4); PG8_BAR;
        PG8_STAGE(PG8_SB(1, 0), cB + kstep, voffB); PG8_STAGE(PG8_SA(1, 0), cA + kstep, voffA); PG8_STAGE(PG8_SB(1, 1), cB + hstepB + kstep, voffB);
        PG8_WAIT_V(6); PG8_BAR;
    }
    for (;;) {
        const bool has_next = S.next(ui + 1, nxt);
        const char* nA = has_next ? (const char*)g.A + (size_t)nxt.pm * g.a_tile : cA; const char* nB = has_next ? (const char*)g.Bt + (size_t)nxt.pn * g.b_tile + (size_t)nxt.pm * g.b_pm_koff : cB;
        for (int t = 0; t < nt; t += 2) {
            const bool last = (t == nt - 2);
            const char* a1 = cA + (size_t)(t + 1) * kstep;
            const char* a2 = last ? nA : cA + (size_t)(t + 2) * kstep; const char* b2 = last ? nB : cB + (size_t)(t + 2) * kstep;
            const char* a3 = a2 + kstep; const char* b3 = b2 + kstep;
            if (last && has_next) S.a_ready(nxt);
            if constexpr (SP2) {
            PG8_LDB(B0, 0, 0); PG8_LDB(B1, 0, 1); PG8_SCHED; PG8_LDA(At, 0, 0); PG8_STAGE(PG8_SA(1, 1), a1 + hstepA, voffA);
            PG8_WAIT_V(8); PG8_WAIT_L(0); PG8_BAR; PG8_MMA(0, 0, At, B0); PG8_MMA(0, 1, At, B1); PG8_BAR; PG8_SCHED;
            PG8_LDA(At, 0, 1); PG8_STAGE(PG8_SB(0, 0), b2, voffB); PG8_STAGE(PG8_SB(0, 1), b2 + hstepB, voffB); PG8_STAGE(PG8_SA(0, 0), a2, voffA);
            PG8_WAIT_V(8); PG8_WAIT_L(0); PG8_BAR; PG8_MMA(1, 0, At, B0); PG8_MMA(1, 1, At, B1); PG8_BAR; PG8_SCHED;
            PG8_LDB(B0, 1, 0); PG8_LDB(B1, 1, 1); PG8_SCHED; PG8_LDA(At, 1, 0); PG8_STAGE(PG8_SA(0, 1), a2 + hstepA, voffA);
            PG8_WAIT_V(8); PG8_WAIT_L(0); PG8_BAR; PG8_MMA(0, 0, At, B0); PG8_MMA(0, 1, At, B1); PG8_BAR; PG8_SCHED;
            PG8_LDA(At, 1, 1); PG8_STAGE(PG8_SB(1, 0), b3, voffB); PG8_STAGE(PG8_SB(1, 1), b3 + hstepB, voffB); PG8_STAGE(PG8_SA(1, 0), a3, voffA);
            PG8_WAIT_V(8); PG8_WAIT_L(0); PG8_BAR; PG8_MMA(1, 0, At, B0); PG8_MMA(1, 1, At, B1); PG8_BAR; PG8_SCHED;
            } else {
            PG8_LDB(B0, 0, 0); PG8_SCHED; PG8_LDA(At, 0, 0); PG8_STAGE(PG8_SA(1, 1), a1 + hstepA, voffA);
            PG8_WAIT_L(8); PG8_BAR; PG8_WAIT_L(0); PG8_MMA(0, 0, At, B0); PG8_BAR; PG8_SCHED;
            PG8_LDB(B1, 0, 1); PG8_STAGE(PG8_SB(0, 0), b2, voffB);
            PG8_BAR; PG8_WAIT_L(0); PG8_MMA(0, 1, At, B1); PG8_BAR;
            PG8_LDA(At, 0, 1); PG8_STAGE(PG8_SA(0, 0), a2, voffA);
            PG8_BAR; PG8_WAIT_L(0); PG8_MMA(1, 0, At, B0); PG8_BAR; PG8_SCHED;
            PG8_STAGE(PG8_SB(0, 1), b2 + hstepB, voffB);
            PG8_WAIT_V(6); PG8_BAR; PG8_MMA(1, 1, At, B1); PG8_BAR;
            PG8_LDB(B0, 1, 0); PG8_SCHED; PG8_LDA(At, 1, 0); PG8_STAGE(PG8_SA(0, 1), a2 + hstepA, voffA);
            PG8_WAIT_L(8); PG8_BAR; PG8_WAIT_L(0); PG8_MMA(0, 0, At, B0); PG8_BAR; PG8_SCHED;
            PG8_LDB(B1, 1, 1); PG8_STAGE(PG8_SB(1, 0), b3, voffB);
            PG8_BAR; PG8_WAIT_L(0); PG8_MMA(0, 1, At, B1); PG8_BAR;
            PG8_LDA(At, 1, 1); PG8_STAGE(PG8_SA(1, 0), a3, voffA);
            PG8_BAR; PG8_WAIT_L(0); PG8_MMA(1, 0, At, B0); PG8_BAR; PG8_SCHED;
            PG8_STAGE(PG8_SB(1, 1), b3 + hstepB, voffB);
            PG8_WAIT_V(6); PG8_BAR; PG8_MMA(1, 1, At, B1); PG8_BAR;
            }
        }
        if constexpr (ALIGN_EPI) { if (wr == 0) PG8_BAR; }
        if constexpr (!Epi::AFTER_DRAIN) { E(acc, cur, wr, wc, fr, fq); S.done(cur); }
        if (!has_next) break;
#pragma unroll
        for (int a = 0; a < 2; ++a)
#pragma unroll
            for (int b = 0; b < 2; ++b)
#pragma unroll
                for (int m = 0; m < 4; ++m)
#pragma unroll
                    for (int n = 0; n < 2; ++n) acc[a][b][m][n] = (f32x4){0.f, 0.f, 0.f, 0.f};
        cur = nxt; cA = nA; cB = nB; ++ui;
        if constexpr (ALIGN_EPI) { if (wr == 1) PG8_BAR; }
    }
    PG8_WAIT_V(0);
    if constexpr (!ALIGN_EPI) { if (wr == 0) PG8_BAR; }
    PG8_BAR;
    if constexpr (Epi::AFTER_DRAIN) { E.fused(acc, cur, wr, wc, fr, fq, lds, wid, lane); S.done(cur); }
#undef PG8_SA
#undef PG8_SB
#undef PG8_STAGE
#undef PG8_LDA
#undef PG8_LDB
#undef PG8_MMA
#undef PG8_WAIT_V
#undef PG8_WAIT_L
#undef PG8_BAR
#undef PG8_SCHED
}
}

using pg8::h16; using pg8::h16x8; using pg8::f32x4; using pg8::f32x2; using pg8::u32x4; using pg8::u32x2; using pg8::pk_h2;
#define LAS __attribute__((address_space(3)))
constexpr int NWAVES = 8;
constexpr int D = 1024, BATCH = 8, SEQ = 4096, M = BATCH * SEQ, FF = 2816, NH = 16, HD = 64;
constexpr float LN_EPS = 1e-5f;
constexpr size_t MiB = 1u << 20;
constexpr size_t WS_MOD = 0;
constexpr size_t WS_STATS = 1 * MiB;
constexpr size_t WS_DFT128 = 1 * MiB + 512 * 1024;
constexpr size_t WS_BAR = 1 * MiB + 768 * 1024;
constexpr size_t WS_WQK = 2 * MiB, WS_WV = 6 * MiB, WS_WO = 8 * MiB, WS_FWO = 10 * MiB, WS_WUP0 = 12 * MiB, WS_WUP1 = 23 * MiB, WS_WDN0 = 34 * MiB, WS_WDN1 = 34 * MiB + 5632 * 1024, WS_EDGE = 46 * MiB;
constexpr size_t WS_U = 80 * MiB, WS_ZA = 144 * MiB, WS_BIG = 272 * MiB, WS_END = 464 * MiB;
constexpr size_t WS_QK = WS_BIG, WS_VT = WS_BIG + 128 * MiB, WS_H = WS_BIG, WS_PQT = WS_BIG, WS_F = WS_BIG + 128 * MiB;
static_assert(WS_WDN1 + 5632 * 1024 <= WS_EDGE && WS_EDGE + (size_t)512 * 6 * 2816 * 4 <= WS_U, "ws map");
constexpr int LDS_BYTES = 152 * 1024;
constexpr int ATT_K_OFF = 0, ATT_V_OFF = 73728, ATT_VSTRIDE = 1160, ATT_B_OFF = ATT_V_OFF + 64 * ATT_VSTRIDE;
static_assert(ATT_B_OFF + 2048 <= LDS_BYTES, "lds map");
constexpr int N_PHASES = 16;
#define PROBE_MASK 0
#define PROBE_SYNC 0

struct Args { const float* in[16]; float* out; unsigned char* ws; int ph_lo, ph_hi, coop, pad; };

__device__ __forceinline__ float wave_sum(float v) {
#pragma unroll
    for (int o = 1; o < 64; o <<= 1) v += __shfl_xor(v, o);
    return v;
}
__device__ __forceinline__ int clipi(int v, int lo, int hi) { return v < lo ? lo : (v > hi ? hi : v); }

template <int KIND>
__device__ __forceinline__ void p0_transpose_item(const float* W, int ldw, int col0, int K, int ncols, h16* WT, LAS float* scr, int item, int lane) {
    const int nblk = ncols / 32, kb = item / nblk, nb = item % nblk, k0 = 64 * kb, n0 = 32 * nb;
#pragma unroll 8
    for (int i = 0; i < 32; ++i) { const int kk = 2 * i + (lane >> 5); scr[kk * 33 + (lane & 31)] = W[(size_t)(k0 + kk) * ldw + col0 + n0 + (lane & 31)]; }
    asm volatile("s_waitcnt lgkmcnt(0)" ::: "memory");
    const int c = lane & 7;
#pragma unroll
    for (int j = 0; j < 4; ++j) { const int n = (lane >> 3) + 8 * j; const LAS float* s = scr + (8 * c) * 33 + n;
        u32x4 o; o.x = pk_h2(s[0 * 33], s[1 * 33]); o.y = pk_h2(s[2 * 33], s[3 * 33]); o.z = pk_h2(s[4 * 33], s[5 * 33]); o.w = pk_h2(s[6 * 33], s[7 * 33]);
        int dr = n0 + n;
        if (KIND == 1) { const int f = dr % FF, isg = dr / FF; dr = (f >> 7) * 256 + isg * 128 + (f & 127); }
        *(u32x4*)(WT + (size_t)dr * K + k0 + 8 * c) = o; }
    asm volatile("s_waitcnt lgkmcnt(0)" ::: "memory");
}

template <int MODE, bool PERMROWS = false>
__device__ __forceinline__ void ln_rows(const float* srcx, const h16* srcz, const float* gam, const float* bet, const float* modsh, const float* modsc, h16* U, float* stats, float* outf, int G, int wid, int lane) {
    const int gw = blockIdx.x * NWAVES + wid, NGW = G * NWAVES;
    f32x4 gm[2][2], bt[2][2];
    if (MODE != 0) {
#pragma unroll
        for (int j = 0; j < 2; ++j)
#pragma unroll
            for (int q = 0; q < 2; ++q) { gm[j][q] = *(const f32x4*)(gam + 8 * lane + 512 * j + 4 * q); bt[j][q] = *(const f32x4*)(bet + 8 * lane + 512 * j + 4 * q); }
    }
    for (int row = gw; row < M; row += NGW) {
        const int b = row >> 12;
        f32x4 v[2][2];
        if (MODE == 0) {
#pragma unroll
            for (int j = 0; j < 2; ++j)
#pragma unroll
                for (int q = 0; q < 2; ++q) v[j][q] = *(const f32x4*)(srcx + (size_t)row * D + 8 * lane + 512 * j + 4 * q);
        } else {
#pragma unroll
            for (int j = 0; j < 2; ++j) { const h16x8 z = *(const h16x8*)(srcz + (size_t)row * D + 8 * lane + 512 * j);
                v[j][0] = (f32x4){(float)z[0], (float)z[1], (float)z[2], (float)z[3]}; v[j][1] = (f32x4){(float)z[4], (float)z[5], (float)z[6], (float)z[7]}; }
            float s = 0.f;
#pragma unroll
            for (int j = 0; j < 2; ++j)
#pragma unroll
                for (int q = 0; q < 2; ++q) s += (v[j][q].x + v[j][q].y) + (v[j][q].z + v[j][q].w);
            const float mean = wave_sum(s) * (1.f / D); float s2 = 0.f;
#pragma unroll
            for (int j = 0; j < 2; ++j)
#pragma unroll
                for (int q = 0; q < 2; ++q) { v[j][q] = v[j][q] - mean; s2 += (v[j][q].x * v[j][q].x + v[j][q].y * v[j][q].y) + (v[j][q].z * v[j][q].z + v[j][q].w * v[j][q].w); }
            const float rstd = 1.f / sqrtf(wave_sum(s2) * (1.f / D) + LN_EPS);
            if (MODE == 1 && lane == 0) *(f32x2*)(stats + 2 * row) = (f32x2){mean, rstd};
#pragma unroll
            for (int j = 0; j < 2; ++j)
#pragma unroll
                for (int q = 0; q < 2; ++q) v[j][q] = v[j][q] * rstd * gm[j][q] + bt[j][q];
        }
        if (MODE == 2) {
#pragma unroll
            for (int j = 0; j < 2; ++j)
#pragma unroll
                for (int q = 0; q < 2; ++q) *(f32x4*)(outf + (size_t)row * D + 8 * lane + 512 * j + 4 * q) = v[j][q];
        } else {
            const int urow = PERMROWS ? ((row & ~4095) | ((row & 63) << 6) | ((row >> 6) & 63)) : row;
#pragma unroll
            for (int j = 0; j < 2; ++j) {
                const float* shp = modsh + b * 6144 + 8 * lane + 512 * j; const float* scp = modsc + b * 6144 + 8 * lane + 512 * j;
                const f32x4 t0 = v[j][0] * (*(const f32x4*)scp + 1.0f) + *(const f32x4*)shp, t1 = v[j][1] * (*(const f32x4*)(scp + 4) + 1.0f) + *(const f32x4*)(shp + 4);
                u32x4 w; w.x = pk_h2(t0.x, t0.y); w.y = pk_h2(t0.z, t0.w); w.z = pk_h2(t1.x, t1.y); w.w = pk_h2(t1.z, t1.w);
                *(u32x4*)(U + (size_t)urow * D + 8 * lane + 512 * j) = w;
            }
        }
    }
}

__device__ __forceinline__ void ffn_fixup_tile(const float* edge, const float* cw, const float* cb, h16* H, int pm, int tid) {
    const int total = 4 * 2 * (FF / 4);
    for (int it = tid; it < total; it += NWAVES * 64) {
        const int f4 = it % (FF / 4), rest = it / (FF / 4), which = rest & 1, blk = pm * 4 + (rest >> 1), f = 4 * f4;
        const float* eb = edge + (size_t)blk * 6 * FF + f;
        f32x4 p, a, q, g; const f32x4 z4 = (f32x4){0.f, 0.f, 0.f, 0.f};
        if (which == 0) { p = ((blk & 63) == 0) ? z4 : *(const f32x4*)(eb - 6 * FF + 3 * FF); a = *(const f32x4*)(eb); q = *(const f32x4*)(eb + FF); g = *(const f32x4*)(eb + 4 * FF); }
        else { p = *(const f32x4*)(eb + 2 * FF); a = *(const f32x4*)(eb + 3 * FF); q = ((blk & 63) == 63) ? z4 : *(const f32x4*)(eb + 6 * FF); g = *(const f32x4*)(eb + 5 * FF); }
        const f32x4 w0 = *(const f32x4*)(cw + f), w1 = *(const f32x4*)(cw + FF + f), w2 = *(const f32x4*)(cw + 2 * FF + f), bb = *(const f32x4*)(cb + f);
        const f32x4 v = bb + w0 * p + w1 * a + w2 * q;
        const int row = blk * 64 + (which ? 63 : 0);
        u32x2 w; w.x = pk_h2(pg8::gelu_tanh(v.x) * g.x, pg8::gelu_tanh(v.y) * g.y); w.y = pk_h2(pg8::gelu_tanh(v.z) * g.z, pg8::gelu_tanh(v.w) * g.w);
        *(u32x2*)(H + (size_t)row * FF + f) = w;
    }
}

__device__ __forceinline__ void attn_stage_row(LAS unsigned char* Kl, LAS unsigned char* Vl, int row, int st_tok, int st_ch, const u32x4& kv, const u32x4& vv) {
    const int slot = row % 9;
    *(LAS u32x4*)(Kl + slot * 8192 + st_tok * 128 + ((st_ch ^ ((st_tok >> 1) & 7)) * 16)) = kv;
    LAS u32x2* p = (LAS u32x2*)(Vl + st_tok * ATT_VSTRIDE + slot * 128 + st_ch * 16); p[0] = (u32x2){vv.x, vv.y}; p[1] = (u32x2){vv.z, vv.w};
}
__device__ __forceinline__ void attn_phase(LAS unsigned char* lds, const h16* QK, const h16* VT, const float* rpb, h16* AO, int G, int tid, int wid, int lane) {
    LAS unsigned char* Kl = lds + ATT_K_OFF; LAS unsigned char* Vl = lds + ATT_V_OFF; LAS float* Bl = (LAS float*)(lds + ATT_B_OFF);
    const int l15 = lane & 15, fq = lane >> 4, qcb = wid & 3, qro = wid >> 2;
    const int cq = qcb * 16 + l15, cs = clipi(cq - 8, 0, 48);
    const int st_tok = tid >> 3, st_ch = tid & 7;
    const float L2E = 1.44269504089f;
    for (int run = blockIdx.x; run < 256; run += G) {
        const int bh = run >> 1, b = bh >> 4, h = bh & 15, rp0 = (run & 1) * 16;
        const h16* kbase = QK + (size_t)(b * SEQ + st_tok) * 2048 + 1024 + h * 64 + st_ch * 8;
        const h16* vbase = VT + (size_t)(h * 64 + st_tok) * M + b * SEQ + st_ch * 8;
        const h16* qbase = QK + (size_t)(b * SEQ + cq) * 2048 + h * 64 + fq * 8;
        __syncthreads();
        if (tid < 465) Bl[tid] = rpb[h * 465 + tid];
        int prev_uhi;
        {   const int r0 = 2 * rp0, ulo = clipi(r0 - 4, 0, 56), uhi = clipi(r0 - 3, 0, 56) + 7;
#pragma unroll 3
            for (int row = ulo; row <= uhi; ++row) { const u32x4 kv = *(const u32x4*)(kbase + (size_t)row * 64 * 2048), vv = *(const u32x4*)(vbase + row * 64); attn_stage_row(Kl, Vl, row, st_tok, st_ch, kv, vv); }
            prev_uhi = uhi; }
        h16x8 nq0 = *(const h16x8*)(qbase + (size_t)(2 * rp0 + qro) * 64 * 2048), nq1 = *(const h16x8*)(qbase + (size_t)(2 * rp0 + qro) * 64 * 2048 + 32);
        u32x4 nk[2], nv[2]; int nrow0 = 0, nnew = 0;
#pragma unroll 1
        for (int sidx = 0; sidx < 16; ++sidx) {
            const int rp = rp0 + sidx, r0 = 2 * rp;
            if (sidx > 0) { __syncthreads();
                if (nnew > 0) attn_stage_row(Kl, Vl, nrow0, st_tok, st_ch, nk[0], nv[0]);
                if (nnew > 1) attn_stage_row(Kl, Vl, nrow0 + 1, st_tok, st_ch, nk[1], nv[1]); }
            __syncthreads();
            const h16x8 q0 = nq0, q1 = nq1;
            if (sidx + 1 < 16) {
                const int n_r0 = r0 + 2, n_uhi = clipi(n_r0 - 3, 0, 56) + 7;
                nrow0 = prev_uhi + 1; nnew = n_uhi - prev_uhi; prev_uhi = n_uhi;
                if (nnew > 0) { nk[0] = *(const u32x4*)(kbase + (size_t)nrow0 * 64 * 2048); nv[0] = *(const u32x4*)(vbase + nrow0 * 64); }
                if (nnew > 1) { nk[1] = *(const u32x4*)(kbase + (size_t)(nrow0 + 1) * 64 * 2048); nv[1] = *(const u32x4*)(vbase + (nrow0 + 1) * 64); }
                nq0 = *(const h16x8*)(qbase + (size_t)(n_r0 + qro) * 64 * 2048); nq1 = *(const h16x8*)(qbase + (size_t)(n_r0 + qro) * 64 * 2048 + 32);
            }
            const int qr = r0 + qro, rs = clipi(qr - 4, 0, 56);
            const int slot0 = rs % 9;
            float mrun = -INFINITY, lsum = 0.f;
            f32x4 o[4];
#pragma unroll
            for (int db = 0; db < 4; ++db) o[db] = (f32x4){0.f, 0.f, 0.f, 0.f};
#pragma unroll
            for (int i2 = 0; i2 < 4; ++i2) {
                int slotv[2];
                f32x4 sc[2][3];
                float mloc = -INFINITY;
#pragma unroll
                for (int e = 0; e < 2; ++e) {
                    const int i = 2 * i2 + e; int sl = slot0 + i; sl = sl >= 9 ? sl - 9 : sl; slotv[e] = sl;
                    const LAS float* brow = Bl + (rs + i - qr + 7) * 31;
#pragma unroll
                    for (int t = 0; t < 3; ++t) {
                        const int kcbr = qcb - 1 + t, kcb = clipi(kcbr, 0, 3); const bool tv = (kcbr == kcb);
                        const int tok = kcb * 16 + l15, sw = (tok >> 1) & 7;
                        const LAS unsigned char* kp = Kl + sl * 8192 + tok * 128;
                        const h16x8 k0 = *(const LAS h16x8*)(kp + ((fq ^ sw) * 16)), k1 = *(const LAS h16x8*)(kp + (((4 + fq) ^ sw) * 16));
                        f32x4 a = (f32x4){0.f, 0.f, 0.f, 0.f};
                        a = __builtin_amdgcn_mfma_f32_16x16x32_f16(k0, q0, a, 0, 0, 0);
                        a = __builtin_amdgcn_mfma_f32_16x16x32_f16(k1, q1, a, 0, 0, 0);
#pragma unroll
                        for (int j = 0; j < 4; ++j) { const int kc = kcb * 16 + 4 * fq + j; const bool ok = tv && (kc >= cs) && (kc < cs + 16); const int dc = clipi(kc - cq + 15, 0, 30);
                            const float bv = brow[dc]; const float v = (a[j] + bv) + (ok ? 0.f : -INFINITY); a[j] = v; mloc = fmaxf(mloc, v); }
                        sc[e][t] = a;
                    }
                }
                mloc = fmaxf(mloc, __shfl_xor(mloc, 16)); mloc = fmaxf(mloc, __shfl_xor(mloc, 32));
                const float mnew = fmaxf(mrun, mloc), alpha = __builtin_amdgcn_exp2f((mrun - mnew) * L2E), mb = mnew * L2E;
                mrun = mnew; lsum *= alpha;
#pragma unroll
                for (int db = 0; db < 4; ++db) o[db] = o[db] * alpha;
#pragma unroll
                for (int t = 0; t < 3; ++t) {
                    const int kcb = clipi(qcb - 1 + t, 0, 3);
                    h16x8 p;
#pragma unroll
                    for (int e = 0; e < 2; ++e)
#pragma unroll
                        for (int j = 0; j < 4; ++j) { const float pe = __builtin_amdgcn_exp2f(sc[e][t][j] * L2E - mb); lsum += pe; p[4 * e + j] = (h16)pe; }
                    const int tofs = (kcb * 16 + 4 * fq) * 2;
#pragma unroll
                    for (int db = 0; db < 4; ++db) {
                        const LAS unsigned char* vp = Vl + (db * 16 + l15) * ATT_VSTRIDE + tofs;
                        const u32x2 lo = *(const LAS u32x2*)(vp + slotv[0] * 128), hi = *(const LAS u32x2*)(vp + slotv[1] * 128);
                        const u32x4 vw = (u32x4){lo.x, lo.y, hi.x, hi.y};
                        o[db] = __builtin_amdgcn_mfma_f32_16x16x32_f16(__builtin_bit_cast(h16x8, vw), p, o[db], 0, 0, 0);
                    }
                }
            }
            lsum += __shfl_xor(lsum, 16); lsum += __shfl_xor(lsum, 32);
            const float inv = 1.0f / lsum;
            h16* op = AO + (size_t)(b * SEQ + qr * 64 + cq) * D + h * 64 + 4 * fq;
#pragma unroll
            for (int db = 0; db < 4; ++db) { const f32x4 v = o[db] * inv; u32x2 w; w.x = pk_h2(v.x, v.y); w.y = pk_h2(v.z, v.w); *(u32x2*)(op + db * 16) = w; }
        }
    }
    __syncthreads();
}

#define XB_TMO      128
#define XB_XCNT(j)  (256  + 64 * (j))
#define XB_XSUB(j)  (1280 + 64 * (j))
#define XB_XGEN(j)  (2304 + 64 * (j))
#define XB_TOP      3328
#define XB_TOPGEN   3392
#define XCD_BAR_WORDS 3456
#define XB_SPIN_CAP (1u << 18)

__device__ __forceinline__ unsigned xb_ld(unsigned* p)              { return __hip_atomic_load(p, __ATOMIC_RELAXED, __HIP_MEMORY_SCOPE_AGENT); }
__device__ __forceinline__ unsigned xb_add(unsigned* p, unsigned v) { return __hip_atomic_fetch_add(p, v, __ATOMIC_RELAXED, __HIP_MEMORY_SCOPE_AGENT); }
__device__ __forceinline__ unsigned xb_xcc_id() { return (unsigned)__builtin_amdgcn_s_getreg((3 << 11) | 20) & 0xFu; }
#define XB_SPIN(cond, bar) do { unsigned _sp = 0; while (cond) { __builtin_amdgcn_s_sleep(1); \
    if ((++_sp & 255u) == 0u) { if (xb_ld(&(bar)[XB_TMO])) break; if (_sp > XB_SPIN_CAP) { atomicAdd(&(bar)[XB_TMO], 1u); break; } } } } while (0)

struct XcdBarrier {
    unsigned* bar; unsigned x;
    volatile LAS unsigned* st;
};

__device__ __forceinline__ XcdBarrier xcd_barrier_post(unsigned* bar, volatile LAS unsigned* st) {
    XcdBarrier b; b.bar = bar; b.x = xb_xcc_id(); b.st = st;
    if (threadIdx.x == 0) (void)xb_add(&bar[XB_XCNT(b.x)], 1u);
    return b;
}
__device__ __forceinline__ void xcd_barrier_complete(unsigned* bar, unsigned x, unsigned& nloc, unsigned& nx) {
    const unsigned G = gridDim.x * gridDim.y * gridDim.z;
    unsigned sum, cnt, mine, sp = 0u;
    for (;;) {
        sum = 0u; cnt = 0u; mine = 0u;
#pragma unroll
        for (unsigned j = 0; j < 16; ++j) { const unsigned c = xb_ld(&bar[XB_XCNT(j)]); sum += c; cnt += (c > 0u) ? 1u : 0u; mine = (j == x) ? c : mine; }
        if (sum == G) break;
        __builtin_amdgcn_s_sleep(1);
        if ((++sp & 255u) == 0u) { if (xb_ld(&bar[XB_TMO])) break; if (sp > XB_SPIN_CAP) { atomicAdd(&bar[XB_TMO], 1u); break; } }
    }
    nloc = mine > 0u ? mine : 1u; nx = cnt > 0u ? cnt : 1u;
}

__device__ __forceinline__ void xcd_barrier(const XcdBarrier& b) {
    asm volatile("s_waitcnt vmcnt(0)" ::: "memory");
    __syncthreads();
    if (threadIdx.x == 0) {
        unsigned* bar = b.bar;
        __builtin_amdgcn_s_waitcnt(0);
        unsigned nloc = b.st[0], nx = b.st[1];
        if (nloc == 0u) { xcd_barrier_complete(bar, b.x, nloc, nx); b.st[0] = nloc; b.st[1] = nx; }
        const unsigned old = xb_add(&bar[XB_XSUB(b.x)], 1u);
        const unsigned gen = old / nloc;
        if (old + 1u == (gen + 1u) * nloc) {
            __builtin_amdgcn_fence(__ATOMIC_RELEASE, "agent");
            asm volatile("s_waitcnt vmcnt(0)" ::: "memory");
            const unsigned og = xb_add(&bar[XB_TOP], 1u);
            const unsigned tg = og / nx;
            if (og + 1u == (tg + 1u) * nx) xb_add(&bar[XB_TOPGEN], 1u);
            else XB_SPIN(xb_ld(&bar[XB_TOPGEN]) == tg, bar);
            __builtin_amdgcn_fence(__ATOMIC_ACQUIRE, "agent");
            xb_add(&bar[XB_XGEN(b.x)], 1u);
            asm volatile("s_waitcnt vmcnt(0)" ::: "memory");
        } else {
            XB_SPIN(xb_ld(&bar[XB_XGEN(b.x)]) == gen, bar);
            __builtin_amdgcn_fence(__ATOMIC_ACQUIRE, "agent");
            asm volatile("s_waitcnt vmcnt(0)" ::: "memory");
        }
    }
    __syncthreads();
}


constexpr int DF_TW_OFF = 0, DF_OM_OFF = 32768, DF_PHI_OFF = 65536, DF_OUT_OFF = 81920, DF_OUT_ROW = 136;
static_assert(DF_OUT_OFF + 8 * 64 * DF_OUT_ROW <= LDS_BYTES, "dft lds map");
__device__ __forceinline__ void dft2d_phase(LAS unsigned char* lds, const h16* PQT, h16* Y, int G, int tid, int wid, int lane) {
    LAS f32x2* TW = (LAS f32x2*)(lds + DF_TW_OFF);
    LAS unsigned char* OmL = lds + DF_OM_OFF;
    LAS unsigned char* Ol = lds + DF_OUT_OFF;
    const int n = lane & 15, kq = lane >> 4;
    for (int i = tid; i < 4096; i += 512) { float sn, cs; sincospif((float)i * (1.0f / 2048.0f), &sn, &cs); TW[i] = (f32x2){cs, sn}; }
    __syncthreads();
    for (int f = wid; f < 32; f += NWAVES) {
        const int nt = f >> 2, ks = f & 3, p = 16 * (nt >> 1) + n, rip = nt & 1, ri = ks >> 1;
        h16x8 v;
#pragma unroll
        for (int e = 0; e < 8; ++e) { const int a = 32 * (ks & 1) + 8 * kq + e; const f32x2 t = TW[((p * a) & 63) * 64];
            const float val = (rip == ri) ? t.x : (rip == 0 ? t.y : -t.y);
            v[e] = (h16)(val * 0.125f); }
        *(LAS h16x8*)(OmL + (f * 64 + lane) * 16) = v;
    }
    LAS unsigned char* PhL = lds + DF_PHI_OFF;
    for (int f = wid; f < 16; f += NWAVES) {
        const int qt = f >> 2, ks2 = f & 3, q = 16 * qt + n;
        h16x8 v;
#pragma unroll
        for (int e = 0; e < 8; ++e) { const int c = 32 * (ks2 & 1) + 16 * (e >> 2) + 4 * kq + (e & 3); const f32x2 t = TW[((q * c) & 63) * 64];
            v[e] = (h16)(((ks2 >> 1) ? t.y : t.x) * 0.125f); }
        *(LAS h16x8*)(PhL + (f * 64 + lane) * 16) = v;
    }
    __syncthreads();
    for (int it = blockIdx.x; it < 1024; it += G) {
        int cb = it;
        if (G == 256) { const int bx = it & 255, i = it >> 8, x = bx & 7, y = bx >> 3; cb = (x * 16 + (y >> 3) * 4 + i) * 8 + (y & 7); }
        const int b = cb >> 7, ch = (cb & 127) * 8 + wid;
        const h16* zp = PQT + (size_t)(b * 1024 + ch) * 8192 + n * 64 + 8 * kq;
        h16x8 zt[4][4];
#pragma unroll
        for (int ct = 0; ct < 4; ++ct)
#pragma unroll
            for (int ks = 0; ks < 4; ++ks) zt[ct][ks] = *(const h16x8*)(zp + (ks >> 1) * 4096 + ct * 1024 + (ks & 1) * 32);
#pragma unroll
        for (int pt = 0; pt < 4; ++pt) {
            f32x4 aR[4], aI[4];
#pragma unroll
            for (int ct = 0; ct < 4; ++ct) { aR[ct] = (f32x4){0.f, 0.f, 0.f, 0.f}; aI[ct] = (f32x4){0.f, 0.f, 0.f, 0.f}; }
#pragma unroll
            for (int ks = 0; ks < 4; ++ks) {
                const h16x8 bR = *(const LAS h16x8*)(OmL + (((2 * pt) * 4 + ks) * 64 + lane) * 16), bI = *(const LAS h16x8*)(OmL + (((2 * pt + 1) * 4 + ks) * 64 + lane) * 16);
#pragma unroll
                for (int ct = 0; ct < 4; ++ct) { aR[ct] = __builtin_amdgcn_mfma_f32_16x16x32_f16(zt[ct][ks], bR, aR[ct], 0, 0, 0); aI[ct] = __builtin_amdgcn_mfma_f32_16x16x32_f16(zt[ct][ks], bI, aI[ct], 0, 0, 0); }
            }
            const int p = 16 * pt + n;
            h16x8 tpR[2], tpI[2];
#pragma unroll
            for (int ct = 0; ct < 4; ++ct)
#pragma unroll
                for (int j = 0; j < 4; ++j) { const int c = 16 * ct + 4 * kq + j; const f32x2 t = TW[(c * p) & 4095];
                    const float tr = aR[ct][j], ti = aI[ct][j];
                    tpR[ct >> 1][4 * (ct & 1) + j] = (h16)(tr * t.x + ti * t.y); tpI[ct >> 1][4 * (ct & 1) + j] = (h16)(ti * t.x - tr * t.y); }
#pragma unroll
            for (int qt = 0; qt < 4; ++qt) {
                f32x4 d = (f32x4){0.f, 0.f, 0.f, 0.f};
                const LAS h16x8* ph = (const LAS h16x8*)(PhL + ((qt * 4) * 64 + lane) * 16);
                d = __builtin_amdgcn_mfma_f32_16x16x32_f16(tpR[0], ph[0], d, 0, 0, 0);
                d = __builtin_amdgcn_mfma_f32_16x16x32_f16(tpR[1], ph[64], d, 0, 0, 0);
                d = __builtin_amdgcn_mfma_f32_16x16x32_f16(tpI[0], ph[128], d, 0, 0, 0);
                d = __builtin_amdgcn_mfma_f32_16x16x32_f16(tpI[1], ph[192], d, 0, 0, 0);
                u32x2 w; w.x = pk_h2(d[0], d[1]); w.y = pk_h2(d[2], d[3]);
                *(LAS u32x2*)(Ol + (wid * 64 + 16 * qt + n) * DF_OUT_ROW + (16 * pt + 4 * kq) * 2) = w;
            }
            asm volatile("" ::: "memory");
        }
        __syncthreads();
        {
            h16* yb = Y + (size_t)(b * SEQ) * D + (cb & 127) * 8;
#pragma unroll
            for (int r = 0; r < 8; ++r) {
                const int k = tid + 512 * r, q = k >> 6, p = k & 63;
                unsigned short hv[8];
#pragma unroll
                for (int w = 0; w < 8; ++w) hv[w] = *(const LAS unsigned short*)(Ol + (w * 64 + q) * DF_OUT_ROW + p * 2);
                u32x4 o; o.x = hv[0] | ((unsigned)hv[1] << 16); o.y = hv[2] | ((unsigned)hv[3] << 16); o.z = hv[4] | ((unsigned)hv[5] << 16); o.w = hv[6] | ((unsigned)hv[7] << 16);
                *(u32x4*)(yb + (size_t)k * D) = o;
            }
        }
        __syncthreads();
    }
}

__global__ void __launch_bounds__(NWAVES * 64, 2) mega_fwd(Args args) {
    extern __shared__ __attribute__((aligned(16))) unsigned char lds_raw[];
    LAS unsigned char* lds = (LAS unsigned char*)lds_raw;
    cg::grid_group grid = cg::this_grid();
    const int G = gridDim.x;
#define PHASE_IDS int tid = threadIdx.x; asm volatile("" : "+v"(tid)); const int lane = tid & 63, wid = __builtin_amdgcn_readfirstlane(tid >> 6); (void)lane; (void)wid;
    unsigned char* ws = args.ws;
    const float* x = args.in[0]; const float* cvec = args.in[1]; const float* ada_w = args.in[2]; const float* ada_b = args.in[3];
    const float* w_qkv = args.in[4]; const float* rpb = args.in[5]; const float* na_wo = args.in[6]; const float* fn_wo = args.in[7];
    const float* ln1_g = args.in[8]; const float* ln1_b = args.in[9]; const float* w_up = args.in[10]; const float* conv_w = args.in[11];
    const float* conv_b = args.in[12]; const float* w_down = args.in[13]; const float* ln2_g = args.in[14]; const float* ln2_b = args.in[15];
    float* out = args.out;
    float* mod = (float*)(ws + WS_MOD); float* stats = (float*)(ws + WS_STATS);
    h16* DFT128 = (h16*)(ws + WS_DFT128);
    h16* Wqk_t = (h16*)(ws + WS_WQK); h16* Wv_t = (h16*)(ws + WS_WV); h16* Wo_t = (h16*)(ws + WS_WO); h16* Fwo_t = (h16*)(ws + WS_FWO);
    h16* Wup0 = (h16*)(ws + WS_WUP0); h16* Wup1 = (h16*)(ws + WS_WUP1); h16* Wdn0 = (h16*)(ws + WS_WDN0); h16* Wdn1 = (h16*)(ws + WS_WDN1);
    float* edge = (float*)(ws + WS_EDGE);
    h16* U = (h16*)(ws + WS_U); h16* ZA = (h16*)(ws + WS_ZA); h16* ZB = (h16*)(ws + WS_ZA + 64 * MiB);
    h16* QKb = (h16*)(ws + WS_QK); h16* VTb = (h16*)(ws + WS_VT); h16* Hb = (h16*)(ws + WS_H); h16* PQT = (h16*)(ws + WS_PQT);

    const int lo = args.ph_lo, hi = args.ph_hi;
    unsigned* barw = (unsigned*)(ws + WS_BAR);
    volatile LAS unsigned* bst = (volatile LAS unsigned*)(lds + LDS_BYTES - 16);
    if (args.coop) {
        if (blockIdx.x == 0) for (int i = threadIdx.x; i < XCD_BAR_WORDS; i += NWAVES * 64) barw[i] = 0u;
        if (threadIdx.x < 2) bst[threadIdx.x] = 0u;
        __syncthreads();
    }
    XcdBarrier xbar; xbar.bar = barw; xbar.x = 0; xbar.st = bst;
#define IN(k) (lo <= (k) && (k) < hi)
#define SEAM(k) do { if (IN(k) && IN((k) + 1)) { xcd_barrier(xbar); if (PROBE_SYNC) xcd_barrier(xbar); } } while (0)
#define REPS(k) _Pragma("unroll 1") for (int rep_ = 0; rep_ < ((PROBE_MASK >> (k)) & 1) + 1; ++rep_)
    const size_t T1K = (size_t)256 * 1024 * 2;

    if (IN(0)) REPS(0) { PHASE_IDS
        LAS float* scr = (LAS float*)(lds + wid * 8448);
        const int gw = blockIdx.x * NWAVES + wid, NGW = G * NWAVES;
        constexpr int I_QK = 16 * 64, I_V = 16 * 32, I_O = 16 * 32, I_UP = 16 * 176, I_DN = 44 * 32;
        constexpr int NITEMS = I_QK + I_V + 2 * I_O + 2 * I_UP + 2 * I_DN;
        for (int it = gw; it < NITEMS; it += NGW) {
            int r = it;
            if (r < I_QK) { p0_transpose_item<0>(w_qkv, 3072, 0, 1024, 2048, Wqk_t, scr, r, lane); continue; } r -= I_QK;
            if (r < I_V) { p0_transpose_item<0>(w_qkv, 3072, 2048, 1024, 1024, Wv_t, scr, r, lane); continue; } r -= I_V;
            if (r < I_O) { p0_transpose_item<0>(na_wo, 1024, 0, 1024, 1024, Wo_t, scr, r, lane); continue; } r -= I_O;
            if (r < I_O) { p0_transpose_item<0>(fn_wo, 1024, 0, 1024, 1024, Fwo_t, scr, r, lane); continue; } r -= I_O;
            if (r < I_UP) { p0_transpose_item<1>(w_up, 5632, 0, 1024, 5632, Wup0, scr, r, lane); continue; } r -= I_UP;
            if (r < I_UP) { p0_transpose_item<1>(w_up + (size_t)1024 * 5632, 5632, 0, 1024, 5632, Wup1, scr, r, lane); continue; } r -= I_UP;
            if (r < I_DN) { p0_transpose_item<0>(w_down, 1024, 0, 2816, 1024, Wdn0, scr, r, lane); continue; } r -= I_DN;
            p0_transpose_item<0>(w_down + (size_t)2816 * 1024, 1024, 0, 2816, 1024, Wdn1, scr, r, lane);
        }
        for (int e = blockIdx.x * 512 + tid; e < 256 * 128; e += G * 512) {
            const int row = e >> 7, c = e & 127, ri = row >> 7, m = row & 127; float sn, cs; sincospif((float)((m * c) & 127) * (1.0f / 64.0f), &sn, &cs);
            const float v = (ri ? -sn : cs) * 0.08838834764831845f;
            DFT128[e] = (h16)v;
        }
        __syncthreads();
        LAS float* cs = (LAS float*)(lds + 80 * 1024);
        LAS float* red = (LAS float*)(lds + 112 * 1024);
        if (blockIdx.x < 192) {
            for (int i = tid; i < 8 * 1024; i += 512) { const float v = cvec[i]; cs[i] = v / (1.0f + __expf(-v)); }
            __syncthreads();
            for (int it = blockIdx.x; it < 192; it += G) {
                const int li = it / 96, e0 = (it % 96) * 64;
                const float* wp = ada_w + (size_t)li * 1024 * 6144 + (size_t)(wid * 128) * 6144 + e0 + lane;
                float a[8];
#pragma unroll
                for (int b = 0; b < 8; ++b) a[b] = 0.f;
#pragma unroll 8
                for (int d = 0; d < 128; ++d) { const float w = wp[(size_t)d * 6144];
#pragma unroll
                    for (int b = 0; b < 8; ++b) a[b] += w * cs[b * 1024 + wid * 128 + d]; }
#pragma unroll
                for (int b = 0; b < 8; ++b) red[(wid * 8 + b) * 64 + lane] = a[b];
                __syncthreads();
                { const int b = tid >> 6, col = tid & 63; float s = ada_b[li * 6144 + e0 + col];
#pragma unroll
                  for (int w = 0; w < 8; ++w) s += red[(w * 8 + b) * 64 + col];
                  mod[(size_t)(li * 8 + b) * 6144 + e0 + col] = s; }
                __syncthreads();
            }
        }
    }
    if (IN(0) && IN(1)) { grid.sync(); xbar = xcd_barrier_post(barw, bst); }
    const float* mod0 = mod; const float* mod1 = mod + 8 * 6144;

    if (IN(1)) REPS(1) { PHASE_IDS ln_rows<0>(x, nullptr, nullptr, nullptr, mod0 + 0 * 1024, mod0 + 1 * 1024, U, nullptr, nullptr, G, wid, lane); }
    SEAM(1);
    if (IN(2)) REPS(2) {
        { pg8::Gemm g{U, Wqk_t, 1024, 1024, 1024, T1K, T1K, 0}; pg8::StaticOrder S; S.init(M, 2048, G, (int)blockIdx.x);
          pg8::EpiH16 E{QKb, 2048, 0, 0, 1024, 0.125f};
          pg8::gemm_phase<pg8::EpiH16, pg8::StaticOrder, true, true>(lds, g, S, E); }
        { pg8::Gemm g{Wv_t, U, 1024, 1024, 1024, T1K, T1K, 0}; pg8::StaticOrder S; S.init(1024, M, G, (int)blockIdx.x);
          pg8::EpiH16 E{VTb, M, 0, 0, 0, 1.f};
          pg8::gemm_phase<pg8::EpiH16, pg8::StaticOrder, true, true>(lds, g, S, E); }
    }
    SEAM(2);
    if (IN(3)) REPS(3) { PHASE_IDS attn_phase(lds, QKb, VTb, rpb, U, G, tid, wid, lane); }
    SEAM(3);
    if (IN(4)) REPS(4) { pg8::Gemm g{U, Wo_t, 1024, 1024, 1024, T1K, T1K, 0}; pg8::StaticOrder S; S.init(M, 1024, G, (int)blockIdx.x);
        pg8::EpiRes E{x, nullptr, nullptr, nullptr, nullptr, mod0 + 2 * 1024, ZA};
        pg8::gemm_phase<pg8::EpiRes, pg8::StaticOrder, true, true>(lds, g, S, E); }
    SEAM(4);
#pragma unroll
    for (int L = 0; L < 2; ++L) {
        const int pb = (L == 0) ? 5 : 12;
        const float* modL = L ? mod1 : mod0;
        if (IN(pb)) REPS(pb) { PHASE_IDS ln_rows<1>(nullptr, ZA, ln1_g + L * 1024, ln1_b + L * 1024, modL + 3 * 1024, modL + 4 * 1024, U, stats, nullptr, G, wid, lane); }
        SEAM(pb);
        if (IN(pb + 1)) REPS(pb + 1) { pg8::Gemm g{U, L ? Wup1 : Wup0, 1024, 1024, 1024, T1K, T1K, 0}; pg8::StaticOrder S; S.init(M, 2 * FF, G, (int)blockIdx.x);
            pg8::EpiUp E{conv_w + (size_t)L * 3 * FF, conv_b + L * FF, Hb, edge};
            pg8::gemm_phase<pg8::EpiUp, pg8::StaticOrder, true, true>(lds, g, S, E); }
        SEAM(pb + 1);
        if (IN(pb + 2)) REPS(pb + 2) { pg8::Gemm g{Hb, L ? Wdn1 : Wdn0, FF, FF, FF, (size_t)256 * FF * 2, (size_t)256 * FF * 2, 0}; pg8::StaticOrder S; S.init(M, 1024, G, (int)blockIdx.x);
            { int tid_ = threadIdx.x; asm volatile("" : "+v"(tid_)); pg8::Unit fu; int prev_pm = -1;
              for (int i = 0; S.next(i, fu); ++i) { if (fu.pm != prev_pm) ffn_fixup_tile(edge, conv_w + (size_t)L * 3 * FF, conv_b + L * FF, Hb, fu.pm, tid_); prev_pm = fu.pm; }
              asm volatile("s_waitcnt vmcnt(0)" ::: "memory"); __syncthreads(); }
            pg8::EpiRes E{nullptr, ZA, stats, ln1_g + L * 1024, ln1_b + L * 1024, modL + 5 * 1024, ZB};
            pg8::gemm_phase<pg8::EpiRes, pg8::StaticOrder, true, true>(lds, g, S, E); }
        SEAM(pb + 2);
        if (L == 0) {
            if (IN(8)) REPS(8) { PHASE_IDS
                ln_rows<1, true>(nullptr, ZB, ln2_g, ln2_b, mod1 + 0 * 1024, mod1 + 1 * 1024, U, stats, nullptr, G, wid, lane);
            }
            SEAM(8);
            if (IN(9)) REPS(9) { int k128 = 128; asm volatile("" : "+s"(k128)); pg8::Gemm g{DFT128, U, 128, 1024, k128, 0, T1K, 256}; pg8::StaticOrder S; S.init(8 * 256, M, G, (int)blockIdx.x);
                pg8::EpiF1 E{PQT};
                pg8::gemm_phase<pg8::EpiF1, pg8::StaticOrder, true, true>(lds, g, S, E); }
            SEAM(9);
            if (IN(10)) REPS(10) { PHASE_IDS dft2d_phase(lds, PQT, U, G, tid, wid, lane); }
            SEAM(10);
            if (IN(11)) REPS(11) { pg8::Gemm g{U, Fwo_t, 1024, 1024, 1024, T1K, T1K, 0}; pg8::StaticOrder S; S.init(M, 1024, G, (int)blockIdx.x);
                pg8::EpiRes E{nullptr, ZB, stats, ln2_g, ln2_b, mod1 + 2 * 1024, ZA};
                pg8::gemm_phase<pg8::EpiRes, pg8::StaticOrder, true, true>(lds, g, S, E); }
            SEAM(11);
        }
    }
    if (IN(15)) REPS(15) { PHASE_IDS ln_rows<2>(nullptr, ZB, ln2_g + 1024, ln2_b + 1024, nullptr, nullptr, nullptr, nullptr, out, G, wid, lane); }
#undef IN
#undef SEAM
}

extern "C" void kernel_launch(void* const* d_in, const int* in_sizes, int n_in, void* d_out, int out_size, void* d_ws, size_t ws_size, hipStream_t stream) {
    static int grid = 0;
    if (grid == 0) {
        if (n_in != 16 || out_size != M * D || ws_size < WS_END) { fprintf(stderr, "kernel_launch: unexpected shapes (n_in %d out %d ws %zu)\n", n_in, out_size, ws_size); grid = -1; return; }
        int dev = 0, cus = 0, per_cu = 0;
        hipGetDevice(&dev); hipDeviceGetAttribute(&cus, hipDeviceAttributeMultiprocessorCount, dev);
        if (hipFuncSetAttribute((const void*)mega_fwd, hipFuncAttributeMaxDynamicSharedMemorySize, LDS_BYTES) != hipSuccess) { fprintf(stderr, "kernel_launch: hipFuncSetAttribute failed\n"); grid = -1; return; }
        if (hipOccupancyMaxActiveBlocksPerMultiprocessor(&per_cu, (const void*)mega_fwd, NWAVES * 64, LDS_BYTES) != hipSuccess || per_cu < 1) { fprintf(stderr, "kernel_launch: occupancy query says %d\n", per_cu); per_cu = 1; }
        (void)hipGetLastError();
        grid = cus;
        fprintf(stderr, "kernel_launch: grid %d (cus %d, per_cu %d)\n", grid, cus, per_cu);
    }
    if (grid < 0) return;
    Args a{};
    for (int i = 0; i < 16; ++i) a.in[i] = (const float*)d_in[i];
    a.out = (float*)d_out; a.ws = (unsigned char*)d_ws;
#if MK_ONE_LAUNCH
    a.ph_lo = 0; a.ph_hi = N_PHASES; a.coop = 1;
    void* kargs[] = {&a};
    hipError_t e = hipLaunchCooperativeKernel((const void*)mega_fwd, dim3(grid), dim3(NWAVES * 64), kargs, LDS_BYTES, stream);
    if (e != hipSuccess) fprintf(stderr, "cooperative launch failed: %s (grid %d)\n", hipGetErrorString(e), grid);
#else
    for (int p = 0; p < N_PHASES; ++p) { a.ph_lo = p; a.ph_hi = p + 1; a.coop = 0;
        hipLaunchKernelGGL(mega_fwd, dim3(grid), dim3(NWAVES * 64), LDS_BYTES, stream, a); }
#endif
}
```

```cpp
#include <hip/hip_runtime.h>
#include <hip/hip_cooperative_groups.h>
#include <cstdio>
#include <cstdint>
namespace cg = cooperative_groups;

#ifndef MK_ONE_LAUNCH
#define MK_ONE_LAUNCH 1
#endif

namespace pg8 {
#define PG8_LAS __attribute__((address_space(3)))
typedef _Float16 h16;
typedef _Float16 h16x8 __attribute__((ext_vector_type(8)));
typedef _Float16 h16x2 __attribute__((ext_vector_type(2)));
typedef float f32x4 __attribute__((ext_vector_type(4)));
typedef float f32x2 __attribute__((ext_vector_type(2)));
typedef unsigned u32x4 __attribute__((ext_vector_type(4)));
typedef unsigned u32x2 __attribute__((ext_vector_type(2)));
constexpr int BM = 256, BK = 64, HALF = 128, HTB = HALF * BK * 2  , STAGE_BYTES = 8 * HTB, NXCD = 8, WGM = 8;

__host__ __device__ __forceinline__ int lds_byte(int r, int c) { const int st = (r >> 4) * 2 + (c >> 5), rr = r & 15, cc = c & 31, ob = rr * 64 + cc * 2; return st * 1024 + (ob ^ (((ob >> 9) & 1) << 5)); }
__host__ __device__ __forceinline__ void stage_rc(int b, int& R, int& C) { const int st = b / 1024, sb = b % 1024, swz = sb ^ (((sb >> 9) & 1) << 5); R = (st >> 1) * 16 + swz / 64; C = (st & 1) * 32 + (swz % 64) / 2; }
__host__ __device__ __forceinline__ int perm32(int rho) { const int n = rho >> 4, i = rho & 15; return 8 * (i >> 2) + 4 * n + (i & 3); }

struct Unit { int pm, pn; };
struct Gemm { const h16* A; const h16* Bt; int lda, ldb, K; size_t a_tile, b_tile, b_pm_koff; };

struct StaticOrder {
    int nM, nN, nwg, G, c;
    __host__ __device__ void init(int M, int N, int G_, int c_) { nM = M / BM; nN = N / BM; nwg = nM * nN; G = G_; c = c_; }
    __host__ __device__ bool next(int i, Unit& u) const {
        const long L = (long)i * G + c; if (L >= nwg) return false;
        int wgid = (int)L; { const int q = nwg / NXCD, r = nwg % NXCD, xcd = wgid % NXCD, off = wgid / NXCD; wgid = (xcd < r ? xcd * (q + 1) : r * (q + 1) + (xcd - r) * q) + off; }
        const int nig = WGM * nN, gid = wgid / nig, fm = gid * WGM, gsz = (nM - fm) < WGM ? (nM - fm) : WGM;
        u.pm = fm + ((wgid % nig) % gsz); u.pn = (wgid % nig) / gsz; return true;
    }
    __device__ __forceinline__ void a_ready(const Unit&) const {}
    __device__ __forceinline__ void done(const Unit&) const {}
};

__device__ __forceinline__ unsigned pk_h2(float lo, float hi) { h16x2 v; v.x = (h16)lo; v.y = (h16)hi; return __builtin_bit_cast(unsigned, v); }


struct EpiH16 {
    static constexpr bool PERM = true, AFTER_DRAIN = false;
    h16* O; int ldc; int split_cols; size_t split_stride; int scale_cols; float scale;
    __device__ __forceinline__ void operator()(const f32x4 (&acc)[2][2][4][2], const Unit& u, int wr, int wc, int fr, int fq) const {
        const int row0 = u.pm * BM + wr * 64 + fr; int colt = u.pn * BM; h16* base = O;
        const float sc = (colt < scale_cols) ? scale : 1.f;
        if (split_cols) { const int t = colt / split_cols; base += (size_t)t * split_stride; colt -= t * split_cols; }
        const int col0 = colt + wc * 32 + 8 * fq;
#pragma unroll
        for (int ai = 0; ai < 2; ++ai)
#pragma unroll
            for (int m = 0; m < 4; ++m) { h16* rowp = base + (size_t)(row0 + ai * HALF + m * 16) * ldc + col0;
#pragma unroll
                for (int bj = 0; bj < 2; ++bj) { const f32x4 v0 = acc[ai][bj][m][0] * sc, v1 = acc[ai][bj][m][1] * sc;
                    u32x4 w; w.x = pk_h2(v0[0], v0[1]); w.y = pk_h2(v0[2], v0[3]); w.z = pk_h2(v1[0], v1[1]); w.w = pk_h2(v1[2], v1[3]);
                    *(u32x4*)(rowp + bj * HALF) = w; } }
    }
};

struct EpiF1 {
    static constexpr bool PERM = true, AFTER_DRAIN = false;
    h16* PQT;
    __device__ __forceinline__ void operator()(const f32x4 (&acc)[2][2][4][2], const Unit& u, int wr, int wc, int fr, int fq) const {
        const int b = u.pn >> 4, s0 = (u.pn & 15) * 256 + wc * 32 + 8 * fq;
#pragma unroll
        for (int ai = 0; ai < 2; ++ai)
#pragma unroll
            for (int m = 0; m < 4; ++m) { h16* rowp = PQT + (size_t)(b * 1024 + u.pm * 128 + wr * 64 + m * 16 + fr) * 8192 + ai * 4096 + s0;
#pragma unroll
                for (int bj = 0; bj < 2; ++bj) { const f32x4 v0 = acc[ai][bj][m][0], v1 = acc[ai][bj][m][1];
                    u32x4 w; w.x = pk_h2(v0[0], v0[1]); w.y = pk_h2(v0[2], v0[3]); w.z = pk_h2(v1[0], v1[1]); w.w = pk_h2(v1[2], v1[3]);
                    *(u32x4*)(rowp + bj * HALF) = w; } }
    }
};

struct EpiRes {
    static constexpr bool PERM = true, AFTER_DRAIN = false;
    const float* resx; const h16* resz; const float* stats; const float* gam; const float* bet; const float* gate; h16* out;
    __device__ __forceinline__ void operator()(const f32x4 (&acc)[2][2][4][2], const Unit& u, int wr, int wc, int fr, int fq) const {
        const int b = u.pm >> 4; const float ALPHA = 1.41421356237f;
#pragma unroll
        for (int bj = 0; bj < 2; ++bj) {
            const int col = u.pn * BM + bj * HALF + wc * 32 + 8 * fq;
            f32x4 gt[2], gm[2], bt[2];
#pragma unroll
            for (int n = 0; n < 2; ++n) { gt[n] = *(const f32x4*)(gate + b * 6144 + col + 4 * n) + 1.0f;
                if (resz) { gm[n] = *(const f32x4*)(gam + col + 4 * n); bt[n] = *(const f32x4*)(bet + col + 4 * n); } else { gm[n] = (f32x4){1.f, 1.f, 1.f, 1.f}; bt[n] = (f32x4){0.f, 0.f, 0.f, 0.f}; } }
#pragma unroll
            for (int ai = 0; ai < 2; ++ai)
#pragma unroll
                for (int m = 0; m < 4; ++m) {
                    const int row = u.pm * BM + ai * HALF + wr * 64 + m * 16 + fr;
                    f32x4 r0, r1;
                    if (resz) { const h16x8 z = *(const h16x8*)(resz + (size_t)row * 1024 + col); const f32x2 st = *(const f32x2*)(stats + 2 * row);
                        r0 = (f32x4){(float)z[0], (float)z[1], (float)z[2], (float)z[3]}; r1 = (f32x4){(float)z[4], (float)z[5], (float)z[6], (float)z[7]};
                        r0 = (r0 - st.x) * st.y * gm[0] + bt[0]; r1 = (r1 - st.x) * st.y * gm[1] + bt[1]; }
                    else { r0 = *(const f32x4*)(resx + (size_t)row * 1024 + col); r1 = *(const f32x4*)(resx + (size_t)row * 1024 + col + 4); }
                    const f32x4 o0 = r0 * ALPHA + gt[0] * acc[ai][bj][m][0], o1 = r1 * ALPHA + gt[1] * acc[ai][bj][m][1];
                    u32x4 w; w.x = pk_h2(o0[0], o0[1]); w.y = pk_h2(o0[2], o0[3]); w.z = pk_h2(o1[0], o1[1]); w.w = pk_h2(o1[2], o1[3]);
                    *(u32x4*)(out + (size_t)row * 1024 + col) = w;
                }
        }
    }
};

__device__ __forceinline__ float dpp_prev(float old, float src) {
    return __builtin_bit_cast(float, __builtin_amdgcn_update_dpp(__builtin_bit_cast(int, old), __builtin_bit_cast(int, src), 0x111, 0xf, 0xf, false)); }
__device__ __forceinline__ float dpp_next(float old, float src) {
    return __builtin_bit_cast(float, __builtin_amdgcn_update_dpp(__builtin_bit_cast(int, old), __builtin_bit_cast(int, src), 0x101, 0xf, 0xf, false)); }
__device__ __forceinline__ float dpp_ror1(float src) {
    return __builtin_bit_cast(float, __builtin_amdgcn_update_dpp(0, __builtin_bit_cast(int, src), 0x121, 0xf, 0xf, false)); }
__device__ __forceinline__ float dpp_ror15(float src) {
    return __builtin_bit_cast(float, __builtin_amdgcn_update_dpp(0, __builtin_bit_cast(int, src), 0x12f, 0xf, 0xf, false)); }
__device__ __forceinline__ float gelu_tanh(float v) {
    const float y = v + 0.044715f * v * v * v;
    const float e = __builtin_amdgcn_exp2f(-2.302208198f * y);
    return v * __builtin_amdgcn_rcpf(1.0f + e);
}

struct EpiUp {
    static constexpr bool PERM = true, AFTER_DRAIN = false;
    const float* cw; const float* cb; h16* H; float* edge;
    __device__ __forceinline__ void operator()(const f32x4 (&acc)[2][2][4][2], const Unit& u, int wr, int wc, int fr, int fq) const {
        const int f0 = u.pn * 128 + wc * 32 + 8 * fq;
        f32x4 w0[2], w1[2], w2[2], bb[2];
#pragma unroll
        for (int n = 0; n < 2; ++n) { w0[n] = *(const f32x4*)(cw + f0 + 4 * n); w1[n] = *(const f32x4*)(cw + 2816 + f0 + 4 * n); w2[n] = *(const f32x4*)(cw + 2 * 2816 + f0 + 4 * n); bb[n] = *(const f32x4*)(cb + f0 + 4 * n); }
#pragma unroll
        for (int ai = 0; ai < 2; ++ai) {
            const int blk = u.pm * 4 + ai * 2 + wr;
            float* eb = edge + (size_t)blk * 6 * 2816 + f0;
#pragma unroll
            for (int m = 0; m < 4; ++m) {
                unsigned pk[4];
#pragma unroll
                for (int n = 0; n < 2; ++n) {
                    const f32x4 a = acc[ai][0][m][n], g = acc[ai][1][m][n];
                    f32x4 hv;
#pragma unroll
                    for (int j = 0; j < 4; ++j) {
                        const float po = (m > 0) ? dpp_ror1(acc[ai][0][m > 0 ? m - 1 : 0][n][j]) : 0.f;
                        const float no = (m < 3) ? dpp_ror15(acc[ai][0][m < 3 ? m + 1 : 3][n][j]) : 0.f;
                        const float p = dpp_prev(po, a[j]), q = dpp_next(no, a[j]);
                        const float v = bb[n][j] + w0[n][j] * p + w1[n][j] * a[j] + w2[n][j] * q;
                        hv[j] = gelu_tanh(v) * g[j];
                    }
                    pk[2 * n] = pk_h2(hv[0], hv[1]); pk[2 * n + 1] = pk_h2(hv[2], hv[3]);
                    if (m == 0) { if (fr == 0) { *(f32x4*)(eb + 0 * 2816 + 4 * n) = a; *(f32x4*)(eb + 4 * 2816 + 4 * n) = g; } if (fr == 1) *(f32x4*)(eb + 1 * 2816 + 4 * n) = a; }
                    if (m == 3) { if (fr == 14) *(f32x4*)(eb + 2 * 2816 + 4 * n) = a; if (fr == 15) { *(f32x4*)(eb + 3 * 2816 + 4 * n) = a; *(f32x4*)(eb + 5 * 2816 + 4 * n) = g; } }
                }
                const int row = u.pm * BM + ai * HALF + wr * 64 + m * 16 + fr;
                u32x4 w; w.x = pk[0]; w.y = pk[1]; w.z = pk[2]; w.w = pk[3];
                *(u32x4*)(H + (size_t)row * 2816 + f0) = w;
            }
        }
    }
};

template <class Epi, class Sched, bool ALIGN_EPI = false, bool SP2 = false>
__device__ __forceinline__ void gemm_phase(PG8_LAS unsigned char* lds, const Gemm g, const Sched& S, const Epi& E) {
    int tid_ = threadIdx.x; asm volatile("" : "+v"(tid_));
    const int tid = tid_, wid = __builtin_amdgcn_readfirstlane(tid >> 6), lane = tid & 63, wr = wid >> 2, wc = wid & 3, fr = lane & 15, fq = lane >> 4;
    const int K = g.K, nt = K / BK;
    unsigned voffA[2], voffB[2];
#pragma unroll
    for (int i = 0; i < 2; ++i) { int R, C; stage_rc(tid * 16 + i * 8192, R, C); const int Rb = Epi::PERM ? ((R & ~31) + perm32(R & 31)) : R;
        voffA[i] = (unsigned)(R * g.lda + C) * 2u; voffB[i] = (unsigned)(Rb * g.ldb + C) * 2u; }
    const size_t kstep = (size_t)(BK * 2);
    const size_t hstepA = (size_t)HALF * g.lda * 2, hstepB = (size_t)HALF * g.ldb * 2;
    const unsigned ldsw = (unsigned)wid * 1024u;
    const int aoff = lds_byte(wr * 64 + fr, fq * 8), boff = lds_byte(wc * 32 + fr, fq * 8);
#define PG8_SA(b, h) (((b) * 2 + (h)) * HTB)
#define PG8_SB(b, h) ((4 + (b) * 2 + (h)) * HTB)
#define PG8_STAGE(bufoff, gbase, voff) do { _Pragma("unroll") for (int _i = 0; _i < 2; ++_i) \
        __builtin_amdgcn_global_load_lds((const unsigned*)((const char*)(gbase) + (voff)[_i]), (PG8_LAS unsigned*)(lds + (bufoff) + ldsw + _i * 8192), 16, 0, 0); } while (0)
#define PG8_LDA(dst, b, h) do { _Pragma("unroll") for (int m = 0; m < 4; ++m) _Pragma("unroll") for (int k = 0; k < 2; ++k) dst[m][k] = *(const PG8_LAS h16x8*)(lds + PG8_SA(b, h) + aoff + m * 2048 + k * 1024); } while (0)
#define PG8_LDB(dst, b, h) do { _Pragma("unroll") for (int n = 0; n < 2; ++n) _Pragma("unroll") for (int k = 0; k < 2; ++k) dst[n][k] = *(const PG8_LAS h16x8*)(lds + PG8_SB(b, h) + boff + n * 2048 + k * 1024); } while (0)
#define PG8_MMA(ai, bj, At, Bt) do { __builtin_amdgcn_s_setprio(1); _Pragma("unroll") for (int m = 0; m < 4; ++m) _Pragma("unroll") for (int n = 0; n < 2; ++n) _Pragma("unroll") for (int k = 0; k < 2; ++k) \
        acc[ai][bj][m][n] = __builtin_amdgcn_mfma_f32_16x16x32_f16(Bt[n][k], At[m][k], acc[ai][bj][m][n], 0, 0, 0); __builtin_amdgcn_s_setprio(0); } while (0)
#define PG8_WAIT_V(n) asm volatile("s_waitcnt vmcnt(" #n ")" ::: "memory")
#define PG8_WAIT_L(n) asm volatile("s_waitcnt lgkmcnt(" #n ")" ::: "memory")
#define PG8_BAR __builtin_amdgcn_s_barrier()
#define PG8_SCHED __builtin_amdgcn_sched_barrier(0)
    Unit cur, nxt; int ui = 0;
    if (!S.next(0, cur)) return;
    f32x4 acc[2][2][4][2];
#pragma unroll
    for (int a = 0; a < 2; ++a)
#pragma unroll
        for (int b = 0; b < 2; ++b)
#pragma unroll
            for (int m = 0; m < 4; ++m)
#pragma unroll
                for (int n = 0; n < 2; ++n) acc[a][b][m][n] = (f32x4){0.f, 0.f, 0.f, 0.f};
    h16x8 At[4][2], B0[2][2], B1[2][2];
    const char* cA = (const char*)g.A + (size_t)cur.pm * g.a_tile; const char* cB = (const char*)g.Bt + (size_t)cur.pn * g.b_tile + (size_t)cur.pm * g.b_pm_koff;
    S.a_ready(cur);
    if constexpr (SP2) {
        PG8_STAGE(PG8_SB(0, 0), cB, voffB); PG8_STAGE(PG8_SB(0, 1), cB + hstepB, voffB); PG8_STAGE(PG8_SA(0, 0), cA, voffA); PG8_STAGE(PG8_SA(0, 1), cA + hstepA, voffA);
        if (wr == 1) PG8_BAR;
        PG8_WAIT_V(2); PG8_BAR;
        PG8_STAGE(PG8_SB(1, 0), cB + kstep, voffB); PG8_STAGE(PG8_SA(1, 0), cA + kstep, voffA); PG8_STAGE(PG8_SB(1, 1), cB + hstepB + kstep, voffB);
        PG8_WAIT_V(6); PG8_BAR;
    } else {
        PG8_STAGE(PG8_SB(0, 0), cB, voffB); PG8_STAGE(PG8_SA(0, 0), cA, voffA); PG8_STAGE(PG8_SB(0, 1), cB + hstepB, voffB); PG8_STAGE(PG8_SA(0, 1), cA + hstepA, voffA);
        if (wr == 1) PG8_BAR;
        PG8_WAIT_V(4); PG8_BAR;
        PG8_STAGE(PG8_SB(1, 0), cB + kstep, voffB); PG8_STAGE(PG8_SA(1, 0), cA + kstep, voffA); PG8_STAGE(PG8_SB(1, 1), cB + hstepB + kstep, voffB);
        PG8_WAIT_V(6); PG8_BAR;
    }
    for (;;) {
        const bool has_next = S.next(ui + 1, nxt);
        const char* nA = has_next ? (const char*)g.A + (size_t)nxt.pm * g.a_tile : cA; const char* nB = has_next ? (const char*)g.Bt + (size_t)nxt.pn * g.b_tile + (size_t)nxt.pm * g.b_pm_koff : cB;
        for (int t = 0; t < nt; t += 2) {
            const bool last = (t == nt - 2);
            const char* a1 = cA + (size_t)(t + 1) * kstep;
            const char* a2 = last ? nA : cA + (size_t)(t + 2) * kstep; const char* b2 = last ? nB : cB + (size_t)(t + 2) * kstep;
            const char* a3 = a2 + kstep; const char* b3 = b2 + kstep;
            if (last && has_next) S.a_ready(nxt);
            if constexpr (SP2) {
            PG8_LDB(B0, 0, 0); PG8_LDB(B1, 0, 1); PG8_SCHED; PG8_LDA(At, 0, 0); PG8_STAGE(PG8_SA(1, 1), a1 + hstepA, voffA);
            PG8_WAIT_V(8); PG8_WAIT_L(0); PG8_BAR; PG8_MMA(0, 0, At, B0); PG8_MMA(0, 1, At, B1); PG8_BAR; PG8_SCHED;
            PG8_LDA(At, 0, 1); PG8_STAGE(PG8_SB(0, 0), b2, voffB); PG8_STAGE(PG8_SB(0, 1), b2 + hstepB, voffB); PG8_STAGE(PG8_SA(0, 0), a2, voffA);
            PG8_WAIT_V(8); PG8_WAIT_L(0); PG8_BAR; PG8_MMA(1, 0, At, B0); PG8_MMA(1, 1, At, B1); PG8_BAR; PG8_SCHED;
            PG8_LDB(B0, 1, 0); PG8_LDB(B1, 1, 1); PG8_SCHED; PG8_LDA(At, 1, 0); PG8_STAGE(PG8_SA(0, 1), a2 + hstepA, voffA);
            PG8_WAIT_V(8); PG8_WAIT_L(0); PG8_BAR; PG8_MMA(0, 0, At, B0); PG8_MMA(0, 1, At, B1); PG8_BAR; PG8_SCHED;
            PG8_LDA(At, 1, 1); PG8_STAGE(PG8_SB(1, 0), b3, voffB); PG8_STAGE(PG8_SB(1, 1), b3 + hstepB, voffB); PG8_STAGE(PG8_SA(1, 0), a3, voffA);
            PG8_WAIT_V(8); PG8_WAIT_L(0); PG8_BAR; PG8_MMA(1, 0, At, B0); PG8_MMA(1, 1, At, B1); PG8_BAR; PG8_SCHED;
            } else {
            PG8_LDB(B0, 0, 0); PG8_SCHED; PG8_LDA(At, 0, 0); PG8_STAGE(PG8_SA(1, 1), a1 + hstepA, voffA);
            PG8_WAIT_L(8); PG8_BAR; PG8_WAIT_L(0); PG8_MMA(0, 0, At, B0); PG8_BAR; PG8_SCHED;
            PG8_LDB(B1, 0, 1); PG8_STAGE(PG8_SB(0, 0), b2, voffB);
            PG8_BAR; PG8_WAIT_L(0); PG8_MMA(0, 1, At, B1); PG8_BAR;
            PG8_LDA(At, 0, 1); PG8_STAGE(PG8_SA(0, 0), a2, voffA);
            PG8_BAR; PG8_WAIT_L(0); PG8_MMA(1, 0, At, B0); PG8_BAR; PG8_SCHED;
            PG8_STAGE(PG8_SB(0, 1), b2 + hstepB, voffB);
            PG8_WAIT_V(6); PG8_BAR; PG8_MMA(1, 1, At, B1); PG8_BAR;
            PG8_LDB(B0, 1, 0); PG8_SCHED; PG8_LDA(At, 1, 0); PG8_STAGE(PG8_SA(0, 1), a2 + hstepA, voffA);
            PG8_WAIT_L(8); PG8_BAR; PG8_WAIT_L(0); PG8_MMA(0, 0, At, B0); PG8_BAR; PG8_SCHED;
            PG8_LDB(B1, 1, 1); PG8_STAGE(PG8_SB(1, 0), b3, voffB);
            PG8_BAR; PG8_WAIT_L(0); PG8_MMA(0, 1, At, B1); PG8_BAR;
            PG8_LDA(At, 1, 1); PG8_STAGE(PG8_SA(1, 0), a3, voffA);
            PG8_BAR; PG8_WAIT_L(0); PG8_MMA(1, 0, At, B0); PG8_BAR; PG8_SCHED;
            PG8_STAGE(PG8_SB(1, 1), b3 + hstepB, voffB);
            PG8_WAIT_V(6); PG8_BAR; PG8_MMA(1, 1, At, B1); PG8_BAR;
            }
        }
        if constexpr (ALIGN_EPI) { if (wr == 0) PG8_BAR; }
        if constexpr (!Epi::AFTER_DRAIN) { E(acc, cur, wr, wc, fr, fq); S.done(cur); }
        if (!has_next) break;
#pragma unroll
        for (int a = 0; a < 2; ++a)
#pragma unroll
            for (int b = 0; b < 2; ++b)
#pragma unroll
                for (int m = 0; m < 4; ++m)
#pragma unroll
                    for (int n = 0; n < 2; ++n) acc[a][b][m][n] = (f32x4){0.f, 0.f, 0.f, 0.f};
        cur = nxt; cA = nA; cB = nB; ++ui;
        if constexpr (ALIGN_EPI) { if (wr == 1) PG8_BAR; }
    }
    PG8_WAIT_V(0);
    if constexpr (!ALIGN_EPI) { if (wr == 0) PG8_BAR; }
    PG8_BAR;
    if constexpr (Epi::AFTER_DRAIN) { E.fused(acc, cur, wr, wc, fr, fq, lds, wid, lane); S.done(cur); }
#undef PG8_SA
#undef PG8_SB
#undef PG8_STAGE
#undef PG8_LDA
#undef PG8_LDB
#undef PG8_MMA
#undef PG8_WAIT_V
#undef PG8_WAIT_L
#undef PG8_BAR
#undef PG8_SCHED
}
}

using pg8::h16; using pg8::h16x8; using pg8::f32x4; using pg8::f32x2; using pg8::u32x4; using pg8::u32x2; using pg8::pk_h2;
#define LAS __attribute__((address_space(3)))
constexpr int NWAVES = 8;
constexpr int D = 1024, BATCH = 8, SEQ = 4096, M = BATCH * SEQ, FF = 2816, NH = 16, HD = 64;
constexpr float LN_EPS = 1e-5f;
constexpr size_t MiB = 1u << 20;
constexpr size_t WS_MOD = 0;
constexpr size_t WS_STATS = 1 * MiB;
constexpr size_t WS_DFT128 = 1 * MiB + 512 * 1024;
constexpr size_t WS_BAR = 1 * MiB + 768 * 1024;
constexpr size_t WS_WQK = 2 * MiB, WS_WV = 6 * MiB, WS_WO = 8 * MiB, WS_FWO = 10 * MiB, WS_WUP0 = 12 * MiB, WS_WUP1 = 23 * MiB, WS_WDN0 = 34 * MiB, WS_WDN1 = 34 * MiB + 5632 * 1024, WS_EDGE = 46 * MiB;
constexpr size_t WS_U = 80 * MiB, WS_ZA = 144 * MiB, WS_BIG = 272 * MiB, WS_END = 464 * MiB;
constexpr size_t WS_QK = WS_BIG, WS_VT = WS_BIG + 128 * MiB, WS_H = WS_BIG, WS_PQT = WS_BIG, WS_F = WS_BIG + 128 * MiB;
static_assert(WS_WDN1 + 5632 * 1024 <= WS_EDGE && WS_EDGE + (size_t)512 * 6 * 2816 * 4 <= WS_U, "ws map");
constexpr int LDS_BYTES = 152 * 1024;
constexpr int ATT_K_OFF = 0, ATT_V_OFF = 73728, ATT_VSTRIDE = 1160, ATT_B_OFF = ATT_V_OFF + 64 * ATT_VSTRIDE;
static_assert(ATT_B_OFF + 2048 <= LDS_BYTES, "lds map");
constexpr int N_PHASES = 16;
#define PROBE_MASK 0
#define PROBE_SYNC 0

struct Args { const float* in[16]; float* out; unsigned char* ws; int ph_lo, ph_hi, coop, pad; };

__device__ __forceinline__ float wave_sum(float v) {
#pragma unroll
    for (int o = 1; o < 64; o <<= 1) v += __shfl_xor(v, o);
    return v;
}
__device__ __forceinline__ int clipi(int v, int lo, int hi) { return v < lo ? lo : (v > hi ? hi : v); }

template <int KIND>
__device__ __forceinline__ void p0_transpose_item(const float* W, int ldw, int col0, int K, int ncols, h16* WT, LAS float* scr, int item, int lane) {
    const int nblk = ncols / 32, kb = item / nblk, nb = item % nblk, k0 = 64 * kb, n0 = 32 * nb;
#pragma unroll 8
    for (int i = 0; i < 32; ++i) { const int kk = 2 * i + (lane >> 5); scr[kk * 33 + (lane & 31)] = W[(size_t)(k0 + kk) * ldw + col0 + n0 + (lane & 31)]; }
    asm volatile("s_waitcnt lgkmcnt(0)" ::: "memory");
    const int c = lane & 7;
#pragma unroll
    for (int j = 0; j < 4; ++j) { const int n = (lane >> 3) + 8 * j; const LAS float* s = scr + (8 * c) * 33 + n;
        u32x4 o; o.x = pk_h2(s[0 * 33], s[1 * 33]); o.y = pk_h2(s[2 * 33], s[3 * 33]); o.z = pk_h2(s[4 * 33], s[5 * 33]); o.w = pk_h2(s[6 * 33], s[7 * 33]);
        int dr = n0 + n;
        if (KIND == 1) { const int f = dr % FF, isg = dr / FF; dr = (f >> 7) * 256 + isg * 128 + (f & 127); }
        *(u32x4*)(WT + (size_t)dr * K + k0 + 8 * c) = o; }
    asm volatile("s_waitcnt lgkmcnt(0)" ::: "memory");
}

template <int MODE, bool PERMROWS = false>
__device__ __forceinline__ void ln_rows(const float* srcx, const h16* srcz, const float* gam, const float* bet, const float* modsh, const float* modsc, h16* U, float* stats, float* outf, int G, int wid, int lane) {
    const int gw = blockIdx.x * NWAVES + wid, NGW = G * NWAVES;
    f32x4 gm[2][2], bt[2][2];
    if (MODE != 0) {
#pragma unroll
        for (int j = 0; j < 2; ++j)
#pragma unroll
            for (int q = 0; q < 2; ++q) { gm[j][q] = *(const f32x4*)(gam + 8 * lane + 512 * j + 4 * q); bt[j][q] = *(const f32x4*)(bet + 8 * lane + 512 * j + 4 * q); }
    }
    for (int row = gw; row < M; row += NGW) {
        const int b = row >> 12;
        f32x4 v[2][2];
        if (MODE == 0) {
#pragma unroll
            for (int j = 0; j < 2; ++j)
#pragma unroll
                for (int q = 0; q < 2; ++q) v[j][q] = *(const f32x4*)(srcx + (size_t)row * D + 8 * lane + 512 * j + 4 * q);
        } else {
#pragma unroll
            for (int j = 0; j < 2; ++j) { const h16x8 z = *(const h16x8*)(srcz + (size_t)row * D + 8 * lane + 512 * j);
                v[j][0] = (f32x4){(float)z[0], (float)z[1], (float)z[2], (float)z[3]}; v[j][1] = (f32x4){(float)z[4], (float)z[5], (float)z[6], (float)z[7]}; }
            float s = 0.f;
#pragma unroll
            for (int j = 0; j < 2; ++j)
#pragma unroll
                for (int q = 0; q < 2; ++q) s += (v[j][q].x + v[j][q].y) + (v[j][q].z + v[j][q].w);
            const float mean = wave_sum(s) * (1.f / D); float s2 = 0.f;
#pragma unroll
            for (int j = 0; j < 2; ++j)
#pragma unroll
                for (int q = 0; q < 2; ++q) { v[j][q] = v[j][q] - mean; s2 += (v[j][q].x * v[j][q].x + v[j][q].y * v[j][q].y) + (v[j][q].z * v[j][q].z + v[j][q].w * v[j][q].w); }
            const float rstd = 1.f / sqrtf(wave_sum(s2) * (1.f / D) + LN_EPS);
            if (MODE == 1 && lane == 0) *(f32x2*)(stats + 2 * row) = (f32x2){mean, rstd};
#pragma unroll
            for (int j = 0; j < 2; ++j)
#pragma unroll
                for (int q = 0; q < 2; ++q) v[j][q] = v[j][q] * rstd * gm[j][q] + bt[j][q];
        }
        if (MODE == 2) {
#pragma unroll
            for (int j = 0; j < 2; ++j)
#pragma unroll
                for (int q = 0; q < 2; ++q) *(f32x4*)(outf + (size_t)row * D + 8 * lane + 512 * j + 4 * q) = v[j][q];
        } else {
            const int urow = PERMROWS ? ((row & ~4095) | ((row & 63) << 6) | ((row >> 6) & 63)) : row;
#pragma unroll
            for (int j = 0; j < 2; ++j) {
                const float* shp = modsh + b * 6144 + 8 * lane + 512 * j; const float* scp = modsc + b * 6144 + 8 * lane + 512 * j;
                const f32x4 t0 = v[j][0] * (*(const f32x4*)scp + 1.0f) + *(const f32x4*)shp, t1 = v[j][1] * (*(const f32x4*)(scp + 4) + 1.0f) + *(const f32x4*)(shp + 4);
                u32x4 w; w.x = pk_h2(t0.x, t0.y); w.y = pk_h2(t0.z, t0.w); w.z = pk_h2(t1.x, t1.y); w.w = pk_h2(t1.z, t1.w);
                *(u32x4*)(U + (size_t)urow * D + 8 * lane + 512 * j) = w;
            }
        }
    }
}

__device__ __forceinline__ void ffn_fixup_tile(const float* edge, const float* cw, const float* cb, h16* H, int pm, int tid) {
    const int total = 4 * 2 * (FF / 4);
    for (int it = tid; it < total; it += NWAVES * 64) {
        const int f4 = it % (FF / 4), rest = it / (FF / 4), which = rest & 1, blk = pm * 4 + (rest >> 1), f = 4 * f4;
        const float* eb = edge + (size_t)blk * 6 * FF + f;
        f32x4 p, a, q, g; const f32x4 z4 = (f32x4){0.f, 0.f, 0.f, 0.f};
        if (which == 0) { p = ((blk & 63) == 0) ? z4 : *(const f32x4*)(eb - 6 * FF + 3 * FF); a = *(const f32x4*)(eb); q = *(const f32x4*)(eb + FF); g = *(const f32x4*)(eb + 4 * FF); }
        else { p = *(const f32x4*)(eb + 2 * FF); a = *(const f32x4*)(eb + 3 * FF); q = ((blk & 63) == 63) ? z4 : *(const f32x4*)(eb + 6 * FF); g = *(const f32x4*)(eb + 5 * FF); }
        const f32x4 w0 = *(const f32x4*)(cw + f), w1 = *(const f32x4*)(cw + FF + f), w2 = *(const f32x4*)(cw + 2 * FF + f), bb = *(const f32x4*)(cb + f);
        const f32x4 v = bb + w0 * p + w1 * a + w2 * q;
        const int row = blk * 64 + (which ? 63 : 0);
        u32x2 w; w.x = pk_h2(pg8::gelu_tanh(v.x) * g.x, pg8::gelu_tanh(v.y) * g.y); w.y = pk_h2(pg8::gelu_tanh(v.z) * g.z, pg8::gelu_tanh(v.w) * g.w);
        *(u32x2*)(H + (size_t)row * FF + f) = w;
    }
}

__device__ __forceinline__ void attn_stage_row(LAS unsigned char* Kl, LAS unsigned char* Vl, int row, int st_tok, int st_ch, const u32x4& kv, const u32x4& vv) {
    const int slot = row % 9;
    *(LAS u32x4*)(Kl + slot * 8192 + st_tok * 128 + ((st_ch ^ ((st_tok >> 1) & 7)) * 16)) = kv;
    LAS u32x2* p = (LAS u32x2*)(Vl + st_tok * ATT_VSTRIDE + slot * 128 + st_ch * 16); p[0] = (u32x2){vv.x, vv.y}; p[1] = (u32x2){vv.z, vv.w};
}
__device__ __forceinline__ void attn_phase(LAS unsigned char* lds, const h16* QK, const h16* VT, const float* rpb, h16* AO, int G, int tid, int wid, int lane) {
    LAS unsigned char* Kl = lds + ATT_K_OFF; LAS unsigned char* Vl = lds + ATT_V_OFF; LAS float* Bl = (LAS float*)(lds + ATT_B_OFF);
    const int l15 = lane & 15, fq = lane >> 4, qcb = wid & 3, qro = wid >> 2;
    const int cq = qcb * 16 + l15, cs = clipi(cq - 8, 0, 48);
    const int st_tok = tid >> 3, st_ch = tid & 7;
    const float L2E = 1.44269504089f;
    for (int run = blockIdx.x; run < 256; run += G) {
        const int bh = run >> 1, b = bh >> 4, h = bh & 15, rp0 = (run & 1) * 16;
        const h16* kbase = QK + (size_t)(b * SEQ + st_tok) * 2048 + 1024 + h * 64 + st_ch * 8;
        const h16* vbase = VT + (size_t)(h * 64 + st_tok) * M + b * SEQ + st_ch * 8;
        const h16* qbase = QK + (size_t)(b * SEQ + cq) * 2048 + h * 64 + fq * 8;
        __syncthreads();
        if (tid < 465) Bl[tid] = rpb[h * 465 + tid];
        int prev_uhi;
        {   const int r0 = 2 * rp0, ulo = clipi(r0 - 4, 0, 56), uhi = clipi(r0 - 3, 0, 56) + 7;
#pragma unroll 3
            for (int row = ulo; row <= uhi; ++row) { const u32x4 kv = *(const u32x4*)(kbase + (size_t)row * 64 * 2048), vv = *(const u32x4*)(vbase + row * 64); attn_stage_row(Kl, Vl, row, st_tok, st_ch, kv, vv); }
            prev_uhi = uhi; }
        h16x8 nq0 = *(const h16x8*)(qbase + (size_t)(2 * rp0 + qro) * 64 * 2048), nq1 = *(const h16x8*)(qbase + (size_t)(2 * rp0 + qro) * 64 * 2048 + 32);
        u32x4 nk[2], nv[2]; int nrow0 = 0, nnew = 0;
#pragma unroll 1
        for (int sidx = 0; sidx < 16; ++sidx) {
            const int rp = rp0 + sidx, r0 = 2 * rp;
            if (sidx > 0) { __syncthreads();
                if (nnew > 0) attn_stage_row(Kl, Vl, nrow0, st_tok, st_ch, nk[0], nv[0]);
                if (nnew > 1) attn_stage_row(Kl, Vl, nrow0 + 1, st_tok, st_ch, nk[1], nv[1]); }
            __syncthreads();
            const h16x8 q0 = nq0, q1 = nq1;
            if (sidx + 1 < 16) {
                const int n_r0 = r0 + 2, n_uhi = clipi(n_r0 - 3, 0, 56) + 7;
                nrow0 = prev_uhi + 1; nnew = n_uhi - prev_uhi; prev_uhi = n_uhi;
                if (nnew > 0) { nk[0] = *(const u32x4*)(kbase + (size_t)nrow0 * 64 * 2048); nv[0] = *(const u32x4*)(vbase + nrow0 * 64); }
                if (nnew > 1) { nk[1] = *(const u32x4*)(kbase + (size_t)(nrow0 + 1) * 64 * 2048); nv[1] = *(const u32x4*)(vbase + (nrow0 + 1) * 64); }
                nq0 = *(const h16x8*)(qbase + (size_t)(n_r0 + qro) * 64 * 2048); nq1 = *(const h16x8*)(qbase + (size_t)(n_r0 + qro) * 64 * 2048 + 32);
            }
            const int qr = r0 + qro, rs = clipi(qr - 4, 0, 56);
            const int slot0 = rs % 9;
            float mrun = -INFINITY, lsum = 0.f;
            f32x4 o[4];
#pragma unroll
            for (int db = 0; db < 4; ++db) o[db] = (f32x4){0.f, 0.f, 0.f, 0.f};
#pragma unroll
            for (int i2 = 0; i2 < 4; ++i2) {
                int slotv[2];
                f32x4 sc[2][3];
                float mloc = -INFINITY;
#pragma unroll
                for (int e = 0; e < 2; ++e) {
                    const int i = 2 * i2 + e; int sl = slot0 + i; sl = sl >= 9 ? sl - 9 : sl; slotv[e] = sl;
                    const LAS float* brow = Bl + (rs + i - qr + 7) * 31;
#pragma unroll
                    for (int t = 0; t < 3; ++t) {
                        const int kcbr = qcb - 1 + t, kcb = clipi(kcbr, 0, 3); const bool tv = (kcbr == kcb);
                        const int tok = kcb * 16 + l15, sw = (tok >> 1) & 7;
                        const LAS unsigned char* kp = Kl + sl * 8192 + tok * 128;
                        const h16x8 k0 = *(const LAS h16x8*)(kp + ((fq ^ sw) * 16)), k1 = *(const LAS h16x8*)(kp + (((4 + fq) ^ sw) * 16));
                        f32x4 a = (f32x4){0.f, 0.f, 0.f, 0.f};
                        a = __builtin_amdgcn_mfma_f32_16x16x32_f16(k0, q0, a, 0, 0, 0);
                        a = __builtin_amdgcn_mfma_f32_16x16x32_f16(k1, q1, a, 0, 0, 0);
#pragma unroll
                        for (int j = 0; j < 4; ++j) { const int kc = kcb * 16 + 4 * fq + j; const bool ok = tv && (kc >= cs) && (kc < cs + 16); const int dc = clipi(kc - cq + 15, 0, 30);
                            const float bv = brow[dc]; const float v = (a[j] + bv) + (ok ? 0.f : -INFINITY); a[j] = v; mloc = fmaxf(mloc, v); }
                        sc[e][t] = a;
                    }
                }
                mloc = fmaxf(mloc, __shfl_xor(mloc, 16)); mloc = fmaxf(mloc, __shfl_xor(mloc, 32));
                const float mnew = fmaxf(mrun, mloc), alpha = __builtin_amdgcn_exp2f((mrun - mnew) * L2E), mb = mnew * L2E;
                mrun = mnew; lsum *= alpha;
#pragma unroll
                for (int db = 0; db < 4; ++db) o[db] = o[db] * alpha;
#pragma unroll
                for (int t = 0; t < 3; ++t) {
                    const int kcb = clipi(qcb - 1 + t, 0, 3);
                    h16x8 p;
#pragma unroll
                    for (int e = 0; e < 2; ++e)
#pragma unroll
                        for (int j = 0; j < 4; ++j) { const float pe = __builtin_amdgcn_exp2f(sc[e][t][j] * L2E - mb); lsum += pe; p[4 * e + j] = (h16)pe; }
                    const int tofs = (kcb * 16 + 4 * fq) * 2;
#pragma unroll
                    for (int db = 0; db < 4; ++db) {
                        const LAS unsigned char* vp = Vl + (db * 16 + l15) * ATT_VSTRIDE + tofs;
                        const u32x2 lo = *(const LAS u32x2*)(vp + slotv[0] * 128), hi = *(const LAS u32x2*)(vp + slotv[1] * 128);
                        const u32x4 vw = (u32x4){lo.x, lo.y, hi.x, hi.y};
                        o[db] = __builtin_amdgcn_mfma_f32_16x16x32_f16(__builtin_bit_cast(h16x8, vw), p, o[db], 0, 0, 0);
                    }
                }
            }
            lsum += __shfl_xor(lsum, 16); lsum += __shfl_xor(lsum, 32);
            const float inv = 1.0f / lsum;
            h16* op = AO + (size_t)(b * SEQ + qr * 64 + cq) * D + h * 64 + 4 * fq;
#pragma unroll
            for (int db = 0; db < 4; ++db) { const f32x4 v = o[db] * inv; u32x2 w; w.x = pk_h2(v.x, v.y); w.y = pk_h2(v.z, v.w); *(u32x2*)(op + db * 16) = w; }
        }
    }
    __syncthreads();
}

#define XB_TMO      128
#define XB_XCNT(j)  (256  + 64 * (j))
#define XB_XSUB(j)  (1280 + 64 * (j))
#define XB_XGEN(j)  (2304 + 64 * (j))
#define XB_TOP      3328
#define XB_TOPGEN   3392
#define XCD_BAR_WORDS 3456
#define XB_SPIN_CAP (1u << 18)

__device__ __forceinline__ unsigned xb_ld(unsigned* p)              { return __hip_atomic_load(p, __ATOMIC_RELAXED, __HIP_MEMORY_SCOPE_AGENT); }
__device__ __forceinline__ unsigned xb_add(unsigned* p, unsigned v) { return __hip_atomic_fetch_add(p, v, __ATOMIC_RELAXED, __HIP_MEMORY_SCOPE_AGENT); }
__device__ __forceinline__ unsigned xb_xcc_id() { return (unsigned)__builtin_amdgcn_s_getreg((3 << 11) | 20) & 0xFu; }
#define XB_SPIN(cond, bar) do { unsigned _sp = 0; while (cond) { __builtin_amdgcn_s_sleep(1); \
    if ((++_sp & 255u) == 0u) { if (xb_ld(&(bar)[XB_TMO])) break; if (_sp > XB_SPIN_CAP) { atomicAdd(&(bar)[XB_TMO], 1u); break; } } } } while (0)

struct XcdBarrier {
    unsigned* bar; unsigned x;
    volatile LAS unsigned* st;
};

__device__ __forceinline__ XcdBarrier xcd_barrier_post(unsigned* bar, volatile LAS unsigned* st) {
    XcdBarrier b; b.bar = bar; b.x = xb_xcc_id(); b.st = st;
    if (threadIdx.x == 0) (void)xb_add(&bar[XB_XCNT(b.x)], 1u);
    return b;
}
__device__ __forceinline__ void xcd_barrier_complete(unsigned* bar, unsigned x, unsigned& nloc, unsigned& nx) {
    const unsigned G = gridDim.x * gridDim.y * gridDim.z;
    unsigned sum, cnt, mine, sp = 0u;
    for (;;) {
        sum = 0u; cnt = 0u; mine = 0u;
#pragma unroll
        for (unsigned j = 0; j < 16; ++j) { const unsigned c = xb_ld(&bar[XB_XCNT(j)]); sum += c; cnt += (c > 0u) ? 1u : 0u; mine = (j == x) ? c : mine; }
        if (sum == G) break;
        __builtin_amdgcn_s_sleep(1);
        if ((++sp & 255u) == 0u) { if (xb_ld(&bar[XB_TMO])) break; if (sp > XB_SPIN_CAP) { atomicAdd(&bar[XB_TMO], 1u); break; } }
    }
    nloc = mine > 0u ? mine : 1u; nx = cnt > 0u ? cnt : 1u;
}

__device__ __forceinline__ void xcd_barrier(const XcdBarrier& b) {
    asm volatile("s_waitcnt vmcnt(0)" ::: "memory");
    __syncthreads();
    if (threadIdx.x == 0) {
        unsigned* bar = b.bar;
        __builtin_amdgcn_s_waitcnt(0);
        unsigned nloc = b.st[0], nx = b.st[1];
        if (nloc == 0u) { xcd_barrier_complete(bar, b.x, nloc, nx); b.st[0] = nloc; b.st[1] = nx; }
        const unsigned old = xb_add(&bar[XB_XSUB(b.x)], 1u);
        const unsigned gen = old / nloc;
        if (old + 1u == (gen + 1u) * nloc) {
            __builtin_amdgcn_fence(__ATOMIC_RELEASE, "agent");
            asm volatile("s_waitcnt vmcnt(0)" ::: "memory");
            const unsigned og = xb_add(&bar[XB_TOP], 1u);
            const unsigned tg = og / nx;
            if (og + 1u == (tg + 1u) * nx) xb_add(&bar[XB_TOPGEN], 1u);
            else XB_SPIN(xb_ld(&bar[XB_TOPGEN]) == tg, bar);
            __builtin_amdgcn_fence(__ATOMIC_ACQUIRE, "agent");
            xb_add(&bar[XB_XGEN(b.x)], 1u);
            asm volatile("s_waitcnt vmcnt(0)" ::: "memory");
        } else {
            XB_SPIN(xb_ld(&bar[XB_XGEN(b.x)]) == gen, bar);
            __builtin_amdgcn_fence(__ATOMIC_ACQUIRE, "agent");
            asm volatile("s_waitcnt vmcnt(0)" ::: "memory");
        }
    }
    __syncthreads();
}


constexpr int DF_TW_OFF = 0, DF_OM_OFF = 32768, DF_PHI_OFF = 65536, DF_OUT_OFF = 81920, DF_OUT_ROW = 136;
static_assert(DF_OUT_OFF + 8 * 64 * DF_OUT_ROW <= LDS_BYTES, "dft lds map");
__device__ __forceinline__ void dft2d_phase(LAS unsigned char* lds, const h16* PQT, h16* Y, int G, int tid, int wid, int lane) {
    LAS f32x2* TW = (LAS f32x2*)(lds + DF_TW_OFF);
    LAS unsigned char* OmL = lds + DF_OM_OFF;
    LAS unsigned char* Ol = lds + DF_OUT_OFF;
    const int n = lane & 15, kq = lane >> 4;
    for (int i = tid; i < 4096; i += 512) { float sn, cs; sincospif((float)i * (1.0f / 2048.0f), &sn, &cs); TW[i] = (f32x2){cs, sn}; }
    __syncthreads();
    for (int f = wid; f < 32; f += NWAVES) {
        const int nt = f >> 2, ks = f & 3, p = 16 * (nt >> 1) + n, rip = nt & 1, ri = ks >> 1;
        h16x8 v;
#pragma unroll
        for (int e = 0; e < 8; ++e) { const int a = 32 * (ks & 1) + 8 * kq + e; const f32x2 t = TW[((p * a) & 63) * 64];
            const float val = (rip == ri) ? t.x : (rip == 0 ? t.y : -t.y);
            v[e] = (h16)(val * 0.125f); }
        *(LAS h16x8*)(OmL + (f * 64 + lane) * 16) = v;
    }
    LAS unsigned char* PhL = lds + DF_PHI_OFF;
    for (int f = wid; f < 16; f += NWAVES) {
        const int qt = f >> 2, ks2 = f & 3, q = 16 * qt + n;
        h16x8 v;
#pragma unroll
        for (int e = 0; e < 8; ++e) { const int c = 32 * (ks2 & 1) + 16 * (e >> 2) + 4 * kq + (e & 3); const f32x2 t = TW[((q * c) & 63) * 64];
            v[e] = (h16)(((ks2 >> 1) ? t.y : t.x) * 0.125f); }
        *(LAS h16x8*)(PhL + (f * 64 + lane) * 16) = v;
    }
    __syncthreads();
    for (int it = blockIdx.x; it < 1024; it += G) {
        int cb = it;
        if (G == 256) { const int bx = it & 255, i = it >> 8, x = bx & 7, y = bx >> 3; cb = (x * 16 + (y >> 3) * 4 + i) * 8 + (y & 7); }
        const int b = cb >> 7, ch = (cb & 127) * 8 + wid;
        const h16* zp = PQT + (size_t)(b * 1024 + ch) * 8192 + n * 64 + 8 * kq;
        h16x8 zt[4][4];
#pragma unroll
        for (int ct = 0; ct < 4; ++ct)
#pragma unroll
            for (int ks = 0; ks < 4; ++ks) zt[ct][ks] = *(const h16x8*)(zp + (ks >> 1) * 4096 + ct * 1024 + (ks & 1) * 32);
#pragma unroll
        for (int pt = 0; pt < 4; ++pt) {
            f32x4 aR[4], aI[4];
#pragma unroll
            for (int ct = 0; ct < 4; ++ct) { aR[ct] = (f32x4){0.f, 0.f, 0.f, 0.f}; aI[ct] = (f32x4){0.f, 0.f, 0.f, 0.f}; }
#pragma unroll
            for (int ks = 0; ks < 4; ++ks) {
                const h16x8 bR = *(const LAS h16x8*)(OmL + (((2 * pt) * 4 + ks) * 64 + lane) * 16), bI = *(const LAS h16x8*)(OmL + (((2 * pt + 1) * 4 + ks) * 64 + lane) * 16);
#pragma unroll
                for (int ct = 0; ct < 4; ++ct) { aR[ct] = __builtin_amdgcn_mfma_f32_16x16x32_f16(zt[ct][ks], bR, aR[ct], 0, 0, 0); aI[ct] = __builtin_amdgcn_mfma_f32_16x16x32_f16(zt[ct][ks], bI, aI[ct], 0, 0, 0); }
            }
            const int p = 16 * pt + n;
            h16x8 tpR[2], tpI[2];
#pragma unroll
            for (int ct = 0; ct < 4; ++ct)
#pragma unroll
                for (int j = 0; j < 4; ++j) { const int c = 16 * ct + 4 * kq + j; const f32x2 t = TW[(c * p) & 4095];
                    const float tr = aR[ct][j], ti = aI[ct][j];
                    tpR[ct >> 1][4 * (ct & 1) + j] = (h16)(tr * t.x + ti * t.y); tpI[ct >> 1][4 * (ct & 1) + j] = (h16)(ti * t.x - tr * t.y); }
#pragma unroll
            for (int qt = 0; qt < 4; ++qt) {
                f32x4 d = (f32x4){0.f, 0.f, 0.f, 0.f};
                const LAS h16x8* ph = (const LAS h16x8*)(PhL + ((qt * 4) * 64 + lane) * 16);
                d = __builtin_amdgcn_mfma_f32_16x16x32_f16(tpR[0], ph[0], d, 0, 0, 0);
                d = __builtin_amdgcn_mfma_f32_16x16x32_f16(tpR[1], ph[64], d, 0, 0, 0);
                d = __builtin_amdgcn_mfma_f32_16x16x32_f16(tpI[0], ph[128], d, 0, 0, 0);
                d = __builtin_amdgcn_mfma_f32_16x16x32_f16(tpI[1], ph[192], d, 0, 0, 0);
                u32x2 w; w.x = pk_h2(d[0], d[1]); w.y = pk_h2(d[2], d[3]);
                *(LAS u32x2*)(Ol + (wid * 64 + 16 * qt + n) * DF_OUT_ROW + (16 * pt + 4 * kq) * 2) = w;
            }
            asm volatile("" ::: "memory");
        }
        __syncthreads();
        {
            h16* yb = Y + (size_t)(b * SEQ) * D + (cb & 127) * 8;
#pragma unroll
            for (int r = 0; r < 8; ++r) {
                const int k = tid + 512 * r, q = k >> 6, p = k & 63;
                unsigned short hv[8];
#pragma unroll
                for (int w = 0; w < 8; ++w) hv[w] = *(const LAS unsigned short*)(Ol + (w * 64 + q) * DF_OUT_ROW + p * 2);
                u32x4 o; o.x = hv[0] | ((unsigned)hv[1] << 16); o.y = hv[2] | ((unsigned)hv[3] << 16); o.z = hv[4] | ((unsigned)hv[5] << 16); o.w = hv[6] | ((unsigned)hv[7] << 16);
                *(u32x4*)(yb + (size_t)k * D) = o;
            }
        }
        __syncthreads();
    }
}

__global__ void __launch_bounds__(NWAVES * 64, 2) mega_fwd(Args args) {
    extern __shared__ __attribute__((aligned(16))) unsigned char lds_raw[];
    LAS unsigned char* lds = (LAS unsigned char*)lds_raw;
    cg::grid_group grid = cg::this_grid();
    const int G = gridDim.x;
#define PHASE_IDS int tid = threadIdx.x; asm volatile("" : "+v"(tid)); const int lane = tid & 63, wid = __builtin_amdgcn_readfirstlane(tid >> 6); (void)lane; (void)wid;
    unsigned char* ws = args.ws;
    const float* x = args.in[0]; const float* cvec = args.in[1]; const float* ada_w = args.in[2]; const float* ada_b = args.in[3];
    const float* w_qkv = args.in[4]; const float* rpb = args.in[5]; const float* na_wo = args.in[6]; const float* fn_wo = args.in[7];
    const float* ln1_g = args.in[8]; const float* ln1_b = args.in[9]; const float* w_up = args.in[10]; const float* conv_w = args.in[11];
    const float* conv_b = args.in[12]; const float* w_down = args.in[13]; const float* ln2_g = args.in[14]; const float* ln2_b = args.in[15];
    float* out = args.out;
    float* mod = (float*)(ws + WS_MOD); float* stats = (float*)(ws + WS_STATS);
    h16* DFT128 = (h16*)(ws + WS_DFT128);
    h16* Wqk_t = (h16*)(ws + WS_WQK); h16* Wv_t = (h16*)(ws + WS_WV); h16* Wo_t = (h16*)(ws + WS_WO); h16* Fwo_t = (h16*)(ws + WS_FWO);
    h16* Wup0 = (h16*)(ws + WS_WUP0); h16* Wup1 = (h16*)(ws + WS_WUP1); h16* Wdn0 = (h16*)(ws + WS_WDN0); h16* Wdn1 = (h16*)(ws + WS_WDN1);
    float* edge = (float*)(ws + WS_EDGE);
    h16* U = (h16*)(ws + WS_U); h16* ZA = (h16*)(ws + WS_ZA); h16* ZB = (h16*)(ws + WS_ZA + 64 * MiB);
    h16* QKb = (h16*)(ws + WS_QK); h16* VTb = (h16*)(ws + WS_VT); h16* Hb = (h16*)(ws + WS_H); h16* PQT = (h16*)(ws + WS_PQT);

    const int lo = args.ph_lo, hi = args.ph_hi;
    unsigned* barw = (unsigned*)(ws + WS_BAR);
    volatile LAS unsigned* bst = (volatile LAS unsigned*)(lds + LDS_BYTES - 16);
    XcdBarrier xbar; xbar.bar = barw; xbar.x = 0; xbar.st = bst;
    if (args.coop) {
        if (threadIdx.x < 2) bst[threadIdx.x] = 0u;
        __syncthreads();
        xbar = xcd_barrier_post(barw, bst);
    }
#define IN(k) (lo <= (k) && (k) < hi)
#define SEAM(k) do { if (IN(k) && IN((k) + 1)) { xcd_barrier(xbar); if (PROBE_SYNC) xcd_barrier(xbar); } } while (0)
#define REPS(k) _Pragma("unroll 1") for (int rep_ = 0; rep_ < ((PROBE_MASK >> (k)) & 1) + 1; ++rep_)
    const size_t T1K = (size_t)256 * 1024 * 2;

    if (IN(0)) REPS(0) { PHASE_IDS
        LAS float* scr = (LAS float*)(lds + wid * 8448);
        const int gw = blockIdx.x * NWAVES + wid, NGW = G * NWAVES;
        constexpr int I_QK = 16 * 64, I_V = 16 * 32, I_O = 16 * 32, I_UP = 16 * 176, I_DN = 44 * 32;
        constexpr int NITEMS = I_QK + I_V + 2 * I_O + 2 * I_UP + 2 * I_DN;
        for (int it = gw; it < NITEMS; it += NGW) {
            int r = it;
            if (r < I_QK) { p0_transpose_item<0>(w_qkv, 3072, 0, 1024, 2048, Wqk_t, scr, r, lane); continue; } r -= I_QK;
            if (r < I_V) { p0_transpose_item<0>(w_qkv, 3072, 2048, 1024, 1024, Wv_t, scr, r, lane); continue; } r -= I_V;
            if (r < I_O) { p0_transpose_item<0>(na_wo, 1024, 0, 1024, 1024, Wo_t, scr, r, lane); continue; } r -= I_O;
            if (r < I_O) { p0_transpose_item<0>(fn_wo, 1024, 0, 1024, 1024, Fwo_t, scr, r, lane); continue; } r -= I_O;
            if (r < I_UP) { p0_transpose_item<1>(w_up, 5632, 0, 1024, 5632, Wup0, scr, r, lane); continue; } r -= I_UP;
            if (r < I_UP) { p0_transpose_item<1>(w_up + (size_t)1024 * 5632, 5632, 0, 1024, 5632, Wup1, scr, r, lane); continue; } r -= I_UP;
            if (r < I_DN) { p0_transpose_item<0>(w_down, 1024, 0, 2816, 1024, Wdn0, scr, r, lane); continue; } r -= I_DN;
            p0_transpose_item<0>(w_down + (size_t)2816 * 1024, 1024, 0, 2816, 1024, Wdn1, scr, r, lane);
        }
        for (int e = blockIdx.x * 512 + tid; e < 256 * 128; e += G * 512) {
            const int row = e >> 7, c = e & 127, ri = row >> 7, m = row & 127; float sn, cs; sincospif((float)((m * c) & 127) * (1.0f / 64.0f), &sn, &cs);
            const float v = (ri ? -sn : cs) * 0.08838834764831845f;
            DFT128[e] = (h16)v;
        }
        __syncthreads();
        LAS float* cs = (LAS float*)(lds + 80 * 1024);
        LAS float* red = (LAS float*)(lds + 112 * 1024);
        if (blockIdx.x < 192) {
            for (int i = tid; i < 8 * 1024; i += 512) { const float v = cvec[i]; cs[i] = v / (1.0f + __expf(-v)); }
            __syncthreads();
            for (int it = blockIdx.x; it < 192; it += G) {
                const int li = it / 96, e0 = (it % 96) * 64;
                const float* wp = ada_w + (size_t)li * 1024 * 6144 + (size_t)(wid * 128) * 6144 + e0 + lane;
                float a[8];
#pragma unroll
                for (int b = 0; b < 8; ++b) a[b] = 0.f;
#pragma unroll 8
                for (int d = 0; d < 128; ++d) { const float w = wp[(size_t)d * 6144];
#pragma unroll
                    for (int b = 0; b < 8; ++b) a[b] += w * cs[b * 1024 + wid * 128 + d]; }
#pragma unroll
                for (int b = 0; b < 8; ++b) red[(wid * 8 + b) * 64 + lane] = a[b];
                __syncthreads();
                { const int b = tid >> 6, col = tid & 63; float s = ada_b[li * 6144 + e0 + col];
#pragma unroll
                  for (int w = 0; w < 8; ++w) s += red[(w * 8 + b) * 64 + col];
                  mod[(size_t)(li * 8 + b) * 6144 + e0 + col] = s; }
                __syncthreads();
            }
        }
    }
    if (args.pad != 0) grid.sync();
    SEAM(0);
    const float* mod0 = mod; const float* mod1 = mod + 8 * 6144;

    if (IN(1)) REPS(1) { PHASE_IDS ln_rows<0>(x, nullptr, nullptr, nullptr, mod0 + 0 * 1024, mod0 + 1 * 1024, U, nullptr, nullptr, G, wid, lane); }
    SEAM(1);
    if (IN(2)) REPS(2) {
        { pg8::Gemm g{U, Wqk_t, 1024, 1024, 1024, T1K, T1K, 0}; pg8::StaticOrder S; S.init(M, 2048, G, (int)blockIdx.x);
          pg8::EpiH16 E{QKb, 2048, 0, 0, 1024, 0.125f};
          pg8::gemm_phase<pg8::EpiH16, pg8::StaticOrder, true, true>(lds, g, S, E); }
        { pg8::Gemm g{Wv_t, U, 1024, 1024, 1024, T1K, T1K, 0}; pg8::StaticOrder S; S.init(1024, M, G, (int)blockIdx.x);
          pg8::EpiH16 E{VTb, M, 0, 0, 0, 1.f};
          pg8::gemm_phase<pg8::EpiH16, pg8::StaticOrder, true, true>(lds, g, S, E); }
    }
    SEAM(2);
    if (IN(3)) REPS(3) { PHASE_IDS attn_phase(lds, QKb, VTb, rpb, U, G, tid, wid, lane); }
    SEAM(3);
    if (IN(4)) REPS(4) { pg8::Gemm g{U, Wo_t, 1024, 1024, 1024, T1K, T1K, 0}; pg8::StaticOrder S; S.init(M, 1024, G, (int)blockIdx.x);
        pg8::EpiRes E{x, nullptr, nullptr, nullptr, nullptr, mod0 + 2 * 1024, ZA};
        pg8::gemm_phase<pg8::EpiRes, pg8::StaticOrder, true, true>(lds, g, S, E); }
    SEAM(4);
#pragma unroll
    for (int L = 0; L < 2; ++L) {
        const int pb = (L == 0) ? 5 : 12;
        const float* modL = L ? mod1 : mod0;
        if (IN(pb)) REPS(pb) { PHASE_IDS ln_rows<1>(nullptr, ZA, ln1_g + L * 1024, ln1_b + L * 1024, modL + 3 * 1024, modL + 4 * 1024, U, stats, nullptr, G, wid, lane); }
        SEAM(pb);
        if (IN(pb + 1)) REPS(pb + 1) { pg8::Gemm g{U, L ? Wup1 : Wup0, 1024, 1024, 1024, T1K, T1K, 0}; pg8::StaticOrder S; S.init(M, 2 * FF, G, (int)blockIdx.x);
            pg8::EpiUp E{conv_w + (size_t)L * 3 * FF, conv_b + L * FF, Hb, edge};
            pg8::gemm_phase<pg8::EpiUp, pg8::StaticOrder, true, true>(lds, g, S, E); }
        SEAM(pb + 1);
        if (IN(pb + 2)) REPS(pb + 2) { pg8::Gemm g{Hb, L ? Wdn1 : Wdn0, FF, FF, FF, (size_t)256 * FF * 2, (size_t)256 * FF * 2, 0}; pg8::StaticOrder S; S.init(M, 1024, G, (int)blockIdx.x);
            { int tid_ = threadIdx.x; asm volatile("" : "+v"(tid_)); pg8::Unit fu; int prev_pm = -1;
              for (int i = 0; S.next(i, fu); ++i) { if (fu.pm != prev_pm) ffn_fixup_tile(edge, conv_w + (size_t)L * 3 * FF, conv_b + L * FF, Hb, fu.pm, tid_); prev_pm = fu.pm; }
              asm volatile("s_waitcnt vmcnt(0)" ::: "memory"); __syncthreads(); }
            pg8::EpiRes E{nullptr, ZA, stats, ln1_g + L * 1024, ln1_b + L * 1024, modL + 5 * 1024, ZB};
            pg8::gemm_phase<pg8::EpiRes, pg8::StaticOrder, true, true>(lds, g, S, E); }
        SEAM(pb + 2);
        if (L == 0) {
            if (IN(8)) REPS(8) { PHASE_IDS
                ln_rows<1, true>(nullptr, ZB, ln2_g, ln2_b, mod1 + 0 * 1024, mod1 + 1 * 1024, U, stats, nullptr, G, wid, lane);
            }
            SEAM(8);
            if (IN(9)) REPS(9) { int k128 = 128; asm volatile("" : "+s"(k128)); pg8::Gemm g{DFT128, U, 128, 1024, k128, 0, T1K, 256}; pg8::StaticOrder S; S.init(8 * 256, M, G, (int)blockIdx.x);
                pg8::EpiF1 E{PQT};
                pg8::gemm_phase<pg8::EpiF1, pg8::StaticOrder, true, true>(lds, g, S, E); }
            SEAM(9);
            if (IN(10)) REPS(10) { PHASE_IDS dft2d_phase(lds, PQT, U, G, tid, wid, lane); }
            SEAM(10);
            if (IN(11)) REPS(11) { pg8::Gemm g{U, Fwo_t, 1024, 1024, 1024, T1K, T1K, 0}; pg8::StaticOrder S; S.init(M, 1024, G, (int)blockIdx.x);
                pg8::EpiRes E{nullptr, ZB, stats, ln2_g, ln2_b, mod1 + 2 * 1024, ZA};
                pg8::gemm_phase<pg8::EpiRes, pg8::StaticOrder, true, true>(lds, g, S, E); }
            SEAM(11);
        }
    }
    if (IN(15)) REPS(15) { PHASE_IDS ln_rows<2>(nullptr, ZB, ln2_g + 1024, ln2_b + 1024, nullptr, nullptr, nullptr, nullptr, out, G, wid, lane); }
#undef IN
#undef SEAM
}

extern "C" void kernel_launch(void* const* d_in, const int* in_sizes, int n_in, void* d_out, int out_size, void* d_ws, size_t ws_size, hipStream_t stream) {
    static int grid = 0;
    if (grid == 0) {
        if (n_in != 16 || out_size != M * D || ws_size < WS_END) { fprintf(stderr, "kernel_launch: unexpected shapes (n_in %d out %d ws %zu)\n", n_in, out_size, ws_size); grid = -1; return; }
        int dev = 0, cus = 0, per_cu = 0;
        hipGetDevice(&dev); hipDeviceGetAttribute(&cus, hipDeviceAttributeMultiprocessorCount, dev);
        if (hipFuncSetAttribute((const void*)mega_fwd, hipFuncAttributeMaxDynamicSharedMemorySize, LDS_BYTES) != hipSuccess) { fprintf(stderr, "kernel_launch: hipFuncSetAttribute failed\n"); grid = -1; return; }
        if (hipOccupancyMaxActiveBlocksPerMultiprocessor(&per_cu, (const void*)mega_fwd, NWAVES * 64, LDS_BYTES) != hipSuccess || per_cu < 1) { fprintf(stderr, "kernel_launch: occupancy query says %d\n", per_cu); per_cu = 1; }
        (void)hipGetLastError();
        grid = cus;
        fprintf(stderr, "kernel_launch: grid %d (cus %d, per_cu %d)\n", grid, cus, per_cu);
    }
    if (grid < 0) return;
    Args a{};
    for (int i = 0; i < 16; ++i) a.in[i] = (const float*)d_in[i];
    a.out = (float*)d_out; a.ws = (unsigned char*)d_ws;
#if MK_ONE_LAUNCH
    if (hipMemsetAsync((char*)d_ws + WS_BAR, 0, XCD_BAR_WORDS * 4, stream) != hipSuccess) { fprintf(stderr, "kernel_launch: memset of the barrier words failed\n"); return; }
    a.ph_lo = 0; a.ph_hi = N_PHASES; a.coop = 1;
    void* kargs[] = {&a};
    hipError_t e = hipLaunchCooperativeKernel((const void*)mega_fwd, dim3(grid), dim3(NWAVES * 64), kargs, LDS_BYTES, stream);
    if (e != hipSuccess) fprintf(stderr, "cooperative launch failed: %s (grid %d)\n", hipGetErrorString(e), grid);
#else
    for (int p = 0; p < N_PHASES; ++p) { a.ph_lo = p; a.ph_hi = p + 1; a.coop = 0;
        hipLaunchKernelGGL(mega_fwd, dim3(grid), dim3(NWAVES * 64), LDS_BYTES, stream, a); }
#endif
}
```
